# Optimizing an MI355X kernel written in HIP

```python
import jax, jax.numpy as jnp
from jax import lax
import numpy as np


D_MODEL = 1024
BATCH = 2
SEQ = 8192
DEPTH = 1

HEAD_DIM = 64
A_HEADS = 8
A_WIDTH = A_HEADS * HEAD_DIM
B_HEADS = 8
B_WIDTH = B_HEADS * HEAD_DIM
B_KV = 2
B_HPG = B_HEADS // B_KV
KV_W = B_KV * HEAD_DIM
N_GATES = B_HEADS * 3
CHUNK = 128
L_CMP = 32
STRIDE_CMP = 16
CMP_HIDDEN = 256
L_SEL = 64
N_SEL = 16
WIN = 512
Q_BLOCK = 128
ROPE_THETA = 10000.0
N_GROUPS = 4
EXPERTS_PER_GROUP = 4
N_EXPERTS = N_GROUPS * EXPERTS_PER_GROUP
TOP_K_IN_GROUP = 2
D_FF_EXPERT = 512
D_PLE = 256
EPS = 1e-6
NEG = -1e30
FORCE = 1e6

OFF_Q = 2 * A_WIDTH
OFF_KV = OFF_Q + B_WIDTH
OFF_GATE = OFF_KV + 6 * KV_W
D_IN = OFF_GATE + N_GATES

kernel_name = 'hymba_gmlp_nsa_hiermoe_ple'


def rmsnorm(x, g):
    xf = x.astype(jnp.float32)
    y = xf * lax.rsqrt(jnp.mean(xf * xf, axis=-1, keepdims=True) + EPS)
    return (y * g.astype(jnp.float32)).astype(x.dtype)


def rope(x, pos):
    half = HEAD_DIM // 2
    inv = 1.0 / (ROPE_THETA ** (jnp.arange(half, dtype=jnp.float32) / half))
    ang = pos.astype(jnp.float32)[:, None] * inv[None, :]
    cos = jnp.cos(ang)[None, :, None, :]
    sin = jnp.sin(ang)[None, :, None, :]
    xf = x.astype(jnp.float32)
    x1, x2 = xf[..., :half], xf[..., half:]
    return jnp.concatenate([x1 * cos - x2 * sin, x1 * sin + x2 * cos], axis=-1).astype(x.dtype)


def masked_softmax(s, mask):
    s = jnp.where(mask, s.astype(jnp.float32), NEG)
    m = jnp.max(s, axis=-1, keepdims=True)
    e = jnp.where(mask, jnp.exp(s - m), 0.0)
    return e / jnp.maximum(jnp.sum(e, axis=-1, keepdims=True), 1e-30)


def chunked_gmlp(u, v, g_v, w_s, b_s):
    bsz, t_len, _ = u.shape
    v = rmsnorm(v, g_v).reshape(bsz, t_len // CHUNK, CHUNK, A_HEADS, HEAD_DIM)
    causal = jnp.tril(jnp.ones((CHUNK, CHUNK), dtype=bool))
    w = jnp.where(causal[None], w_s, 0.0).astype(v.dtype)
    mixed = jnp.einsum('gts,bcsgd->bctgd', w, v) + b_s.T[None, None, :, :, None].astype(v.dtype)
    return u * mixed.reshape(bsz, t_len, A_WIDTH)


def compress(kx, pe, w1, w2):
    bsz, g, t_len, _ = kx.shape
    nc = (t_len - L_CMP) // STRIDE_CMP + 1
    idx = jnp.arange(nc)[:, None] * STRIDE_CMP + jnp.arange(L_CMP)[None, :]
    blocks = kx[:, :, idx] + pe
    flat = blocks.reshape(bsz, g, nc, L_CMP * HEAD_DIM)
    return jax.nn.gelu(flat @ w1) @ w2


def nsa_attention(q, k_cmp, v_cmp, k_slc, v_slc, k_win, v_win, gates,
                  pe_k, w1_k, w2_k, pe_v, w1_v, w2_v):
    bsz, t_len = q.shape[0], q.shape[1]
    qh = q.reshape(bsz, t_len, B_KV, B_HPG, HEAD_DIM).transpose(0, 2, 3, 1, 4)
    gh = gates.reshape(bsz, t_len, B_KV, B_HPG, 3).transpose(0, 2, 3, 1, 4)
    to_g = lambda a: a.transpose(0, 2, 1, 3)

    kc = compress(to_g(k_cmp), pe_k, w1_k, w2_k)
    vc = compress(to_g(v_cmp), pe_v, w1_v, w2_v)
    nc = kc.shape[2]
    c_start = jnp.arange(nc) * STRIDE_CMP
    cmp_end = c_start + L_CMP - 1

    n_sb = t_len // L_SEL
    k_top = min(N_SEL, n_sb)
    s_start = jnp.arange(n_sb) * L_SEL
    overlap = ((c_start[:, None] < s_start[None, :] + L_SEL)
               & (c_start[:, None] + L_CMP > s_start[None, :])).astype(jnp.float32)
    ks_blocks = to_g(k_slc).reshape(bsz, B_KV, n_sb, L_SEL, HEAD_DIM)
    vs_blocks = to_g(v_slc).reshape(bsz, B_KV, n_sb, L_SEL, HEAD_DIM)

    pad = ((0, 0), (0, 0), (WIN, 0), (0, 0))
    kw_pad = jnp.pad(to_g(k_win), pad)
    vw_pad = jnp.pad(to_g(v_win), pad)
    b_idx = jnp.arange(bsz)[:, None, None, None]
    g_idx = jnp.arange(B_KV)[None, :, None, None]
    blk = jnp.arange(n_sb)

    def block(qb):
        start = qb * Q_BLOCK
        qi = lax.dynamic_slice_in_dim(qh, start, Q_BLOCK, axis=3)
        gi = lax.dynamic_slice_in_dim(gh, start, Q_BLOCK, axis=3).astype(jnp.float32)
        t = start + jnp.arange(Q_BLOCK)

        s_c = jnp.einsum('bghqd,bgcd->bghqc', qi, kc)
        p_c = masked_softmax(s_c, cmp_end[None, :] <= t[:, None])
        o_c = jnp.einsum('bghqc,bgcd->bghqd', p_c.astype(vc.dtype), vc)

        imp = jnp.einsum('bgqc,cs->bgqs', jnp.sum(p_c, axis=2), overlap)
        cur = (t // L_SEL)[:, None]
        forced = (blk[None, :] == 0) | (blk[None, :] == cur) | (blk[None, :] == cur - 1)
        valid = s_start[None, :] <= t[:, None]
        score = jnp.where(forced, FORCE, jnp.where(valid, imp, -FORCE))
        _, sel = lax.top_k(score, k_top)

        kg = ks_blocks[b_idx, g_idx, sel]
        vg = vs_blocks[b_idx, g_idx, sel]
        s_s = jnp.einsum('bghqd,bgqkld->bghqkl', qi, kg)
        pos = sel[..., None] * L_SEL + jnp.arange(L_SEL)
        m_s = (pos <= t[None, None, :, None, None])[:, :, None]
        flat_shape = s_s.shape[:4] + (k_top * L_SEL,)
        p_s = masked_softmax(s_s.reshape(flat_shape),
                             m_s.reshape(bsz, B_KV, 1, Q_BLOCK, k_top * L_SEL)).reshape(s_s.shape)
        o_s = jnp.einsum('bghqkl,bgqkld->bghqd', p_s.astype(vg.dtype), vg)

        kwi = lax.dynamic_slice_in_dim(kw_pad, start, Q_BLOCK + WIN, axis=2)
        vwi = lax.dynamic_slice_in_dim(vw_pad, start, Q_BLOCK + WIN, axis=2)
        kpos = start - WIN + jnp.arange(Q_BLOCK + WIN)
        diff = t[:, None] - kpos[None, :]
        m_w = (diff >= 0) & (diff < WIN) & (kpos[None, :] >= 0)
        s_w = jnp.einsum('bghqd,bgkd->bghqk', qi, kwi)
        p_w = masked_softmax(s_w, m_w)
        o_w = jnp.einsum('bghqk,bgkd->bghqd', p_w.astype(vwi.dtype), vwi)

        o = (gi[..., 0:1] * o_c.astype(jnp.float32) + gi[..., 1:2] * o_s.astype(jnp.float32)
             + gi[..., 2:3] * o_w.astype(jnp.float32))
        return o.astype(q.dtype)

    out = lax.map(block, jnp.arange(t_len // Q_BLOCK))
    return out.transpose(1, 0, 4, 2, 3, 5).reshape(bsz, t_len, B_WIDTH)


def hybrid_mixer(hn, w_in, g_v, w_s, b_s, pe_k, w1_k, w2_k, pe_v, w1_v, w2_v, g_out_a, g_out_b, w_o):
    bsz, t_len, _ = hn.shape
    z = hn @ w_in
    zu = jax.nn.gelu(z[..., :2 * A_WIDTH])
    u, v = zu[..., :A_WIDTH], zu[..., A_WIDTH:]
    pos = jnp.arange(t_len)
    q = rope(z[..., OFF_Q:OFF_KV].reshape(bsz, t_len, B_HEADS, HEAD_DIM), pos) * (HEAD_DIM ** -0.5)
    kv = [z[..., OFF_KV + j * KV_W:OFF_KV + (j + 1) * KV_W].reshape(bsz, t_len, B_KV, HEAD_DIM)
          for j in range(6)]
    k_cmp, v_cmp, k_slc, v_slc, k_win, v_win = kv
    k_cmp, k_slc, k_win = rope(k_cmp, pos), rope(k_slc, pos), rope(k_win, pos)
    gates = jax.nn.sigmoid(z[..., OFF_GATE:D_IN].astype(jnp.float32)).reshape(bsz, t_len, B_HEADS, 3)

    oa = chunked_gmlp(u, v, g_v, w_s, b_s)
    ob = nsa_attention(q, k_cmp, v_cmp, k_slc, v_slc, k_win, v_win, gates,
                       pe_k, w1_k, w2_k, pe_v, w1_v, w2_v)
    cat = jnp.concatenate([rmsnorm(oa, g_out_a), rmsnorm(ob, g_out_b)], axis=-1)
    return cat @ w_o


def hier_moe(hn, r_group, r_expert, w_gate, w_up, w_down):
    bsz, t_len, d = hn.shape
    xt = hn.reshape(-1, d)
    pg = jax.nn.softmax((xt @ r_group).astype(jnp.float32), axis=-1)
    pg_top, g_sel = lax.top_k(pg, 1)
    le = (xt @ r_expert).astype(jnp.float32).reshape(-1, N_GROUPS, EXPERTS_PER_GROUP)
    le_sel = jnp.take_along_axis(le, g_sel[:, :, None], axis=1)[:, 0]
    pe = jax.nn.softmax(le_sel, axis=-1)
    pe_top, e_sel = lax.top_k(pe, TOP_K_IN_GROUP)
    w = pg_top * pe_top / jnp.sum(pe_top, axis=-1, keepdims=True)
    eid = g_sel * EXPERTS_PER_GROUP + e_sel
    comb = jnp.einsum('nk,nke->ne', w, jax.nn.one_hot(eid, N_EXPERTS, dtype=jnp.float32))
    y = jnp.zeros(xt.shape, jnp.float32)
    for e in range(N_EXPERTS):
        hid = jax.nn.silu(xt @ w_gate[e]) * (xt @ w_up[e])
        y = y + comb[:, e:e + 1] * (hid @ w_down[e]).astype(jnp.float32)
    return y.astype(hn.dtype).reshape(bsz, t_len, d)


def setup_inputs(seed: int = 0) -> dict:
    key = jax.random.key(seed)
    ks = jax.random.split(key, 26)
    f = jnp.float32
    nrm = lambda k, shape, s: jax.random.normal(k, shape, f) * s
    gain = lambda k, shape: 1.0 + 0.02 * jax.random.normal(k, shape, f)
    return {
        'x': nrm(ks[0], (BATCH, SEQ, D_MODEL), 1.0),
        'p': nrm(ks[1], (DEPTH, BATCH, SEQ, D_PLE), 1.0),
        'norm_mix': gain(ks[2], (DEPTH, D_MODEL)),
        'w_in': nrm(ks[3], (DEPTH, D_MODEL, D_IN), D_MODEL ** -0.5),
        'gmlp_v_norm': gain(ks[4], (DEPTH, A_WIDTH)),
        'gmlp_w_s': nrm(ks[5], (DEPTH, A_HEADS, CHUNK, CHUNK), CHUNK ** -0.5),
        'gmlp_b_s': gain(ks[6], (DEPTH, A_HEADS, CHUNK)),
        'cmp_pe_k': nrm(ks[7], (DEPTH, L_CMP, HEAD_DIM), 0.02),
        'cmp_w1_k': nrm(ks[8], (DEPTH, L_CMP * HEAD_DIM, CMP_HIDDEN), (L_CMP * HEAD_DIM) ** -0.5),
        'cmp_w2_k': nrm(ks[9], (DEPTH, CMP_HIDDEN, HEAD_DIM), CMP_HIDDEN ** -0.5),
        'cmp_pe_v': nrm(ks[10], (DEPTH, L_CMP, HEAD_DIM), 0.02),
        'cmp_w1_v': nrm(ks[11], (DEPTH, L_CMP * HEAD_DIM, CMP_HIDDEN), (L_CMP * HEAD_DIM) ** -0.5),
        'cmp_w2_v': nrm(ks[12], (DEPTH, CMP_HIDDEN, HEAD_DIM), CMP_HIDDEN ** -0.5),
        'out_norm_a': gain(ks[13], (DEPTH, A_WIDTH)),
        'out_norm_b': gain(ks[14], (DEPTH, B_WIDTH)),
        'w_o': nrm(ks[15], (DEPTH, A_WIDTH + B_WIDTH, D_MODEL), (A_WIDTH + B_WIDTH) ** -0.5),
        'norm_moe': gain(ks[16], (DEPTH, D_MODEL)),
        'router_group': nrm(ks[17], (DEPTH, D_MODEL, N_GROUPS), D_MODEL ** -0.5),
        'router_expert': nrm(ks[18], (DEPTH, D_MODEL, N_EXPERTS), D_MODEL ** -0.5),
        'moe_w_gate': nrm(ks[19], (DEPTH, N_EXPERTS, D_MODEL, D_FF_EXPERT), D_MODEL ** -0.5),
        'moe_w_up': nrm(ks[20], (DEPTH, N_EXPERTS, D_MODEL, D_FF_EXPERT), D_MODEL ** -0.5),
        'moe_w_down': nrm(ks[21], (DEPTH, N_EXPERTS, D_FF_EXPERT, D_MODEL), D_FF_EXPERT ** -0.5),
        'norm_ple': gain(ks[22], (DEPTH, D_MODEL)),
        'w_ple_proj': nrm(ks[23], (DEPTH, D_PLE, D_MODEL), D_PLE ** -0.5),
        'w_ple_gate': nrm(ks[24], (DEPTH, D_MODEL, D_MODEL), D_MODEL ** -0.5),
        'norm_final': gain(ks[25], (D_MODEL,)),
    }


def reference(x, p, norm_mix, w_in, gmlp_v_norm, gmlp_w_s, gmlp_b_s,
              cmp_pe_k, cmp_w1_k, cmp_w2_k, cmp_pe_v, cmp_w1_v, cmp_w2_v,
              out_norm_a, out_norm_b, w_o, norm_moe, router_group, router_expert,
              moe_w_gate, moe_w_up, moe_w_down, norm_ple, w_ple_proj, w_ple_gate, norm_final):
    h = x
    for i in range(DEPTH):
        hn = rmsnorm(h, norm_mix[i])
        h = h + hybrid_mixer(hn, w_in[i], gmlp_v_norm[i], gmlp_w_s[i], gmlp_b_s[i],
                             cmp_pe_k[i], cmp_w1_k[i], cmp_w2_k[i],
                             cmp_pe_v[i], cmp_w1_v[i], cmp_w2_v[i],
                             out_norm_a[i], out_norm_b[i], w_o[i])
        h = h + hier_moe(rmsnorm(h, norm_moe[i]), router_group[i], router_expert[i],
                         moe_w_gate[i], moe_w_up[i], moe_w_down[i])
        gate = jax.nn.sigmoid(rmsnorm(h, norm_ple[i]) @ w_ple_gate[i])
        h = h + (p[i] @ w_ple_proj[i]) * gate
    return rmsnorm(h, norm_final)
```

```cpp
#include <hip/hip_runtime.h>
#include <cstdint>
#include <cstdio>

constexpr int D_MODEL = 1024, BATCH = 2, SEQ = 8192, NTOK = BATCH * SEQ;
constexpr int HD = 64, A_WIDTH = 512, B_WIDTH = 512, B_KV = 2, KV_W = 128;
constexpr int N_GATES = 24, CHUNK = 128, L_CMP = 32, STRIDE_CMP = 16, CMP_HIDDEN = 256;
constexpr int L_SEL = 64, N_SEL = 16, WIN = 512, NCMP = 511, NCP = 512, NSB = 128;
constexpr int N_EXPERTS = 16, D_FF = 512, D_PLE = 256;
constexpr int OFF_Q = 1024, OFF_KV = 1536, OFF_GATE = 2304, D_IN = 2328;
constexpr int ZT_W = D_IN - 1024;
constexpr float EPS = 1e-6f;

typedef unsigned short bf16_t;
__device__ __forceinline__ bf16_t f2bf(float f) { unsigned u = __float_as_uint(f); u += 0x7fffu + ((u >> 16) & 1u); return (bf16_t)(u >> 16); }
__device__ __forceinline__ float bf2f(bf16_t h) { return __uint_as_float(((unsigned)h) << 16); }
__device__ __forceinline__ float gelu_tanh(float x) { const float u = 0.7978845608028654f * (x + 0.044715f * x * x * x); return 0.5f * x * (1.0f + tanhf(u)); }
__device__ __forceinline__ float sigmoidf_(float x) { return 1.0f / (1.0f + __expf(-x)); }
__device__ __forceinline__ float wave_sum(float v) {
#pragma unroll
    for (int o = 32; o > 0; o >>= 1) v += __shfl_xor(v, o);
    return v;
}
__device__ __forceinline__ float wave_max(float v) {
#pragma unroll
    for (int o = 32; o > 0; o >>= 1) v = fmaxf(v, __shfl_xor(v, o));
    return v;
}

__device__ const double ROPE_REV[32] = {0.15915494309189535, 0.11934937021124886, 0.08949940160889101, 0.06711508300522726, 0.050329212104487035, 0.03774158471741977, 0.0283021958306234, 0.02122365276477766, 0.015915494309189534, 0.011934937021124886, 0.008949940160889102, 0.006711508300522725, 0.005032921210448704, 0.003774158471741977, 0.00283021958306234, 0.0021223652764777662, 0.0015915494309189536, 0.0011934937021124885, 0.0008949940160889102, 0.0006711508300522726, 0.0005032921210448703, 0.00037741584717419774, 0.00028302195830623395, 0.0002122365276477766, 0.00015915494309189535, 0.00011934937021124886, 8.949940160889102e-05, 6.711508300522725e-05, 5.0329212104487035e-05, 3.774158471741978e-05, 2.8302195830623396e-05, 2.122365276477766e-05};

struct WS {
    float *ropeC, *ropeS;
    bf16_t* HN;
    float* ZT;
    bf16_t *U, *V;
    bf16_t* Q;
    bf16_t* KV[6];
    float* GATES;
    bf16_t *OA, *OB;
    float* CH[2];
    bf16_t* CKV[2];
    bf16_t* CAT;
    bf16_t* HID2;
    float* G;
    int* cnt; int* base; int* ltok; float* lw;
};
static WS make_ws(void* d_ws) {
    WS w; char* p = (char*)d_ws; size_t o = 0;
    auto take = [&](size_t bytes) { char* r = p + o; o += (bytes + 255) & ~(size_t)255; return r; };
    w.ropeC = (float*)take((size_t)SEQ * 32 * 4); w.ropeS = (float*)take((size_t)SEQ * 32 * 4);
    w.HN = (bf16_t*)take((size_t)NTOK * 1024 * 2);
    w.ZT = (float*)take((size_t)NTOK * ZT_W * 4);
    w.U = (bf16_t*)take((size_t)NTOK * 512 * 2); w.V = (bf16_t*)take((size_t)NTOK * 512 * 2);
    w.Q = (bf16_t*)take((size_t)NTOK * 512 * 2);
    for (int j = 0; j < 6; ++j) w.KV[j] = (bf16_t*)take((size_t)NTOK * 128 * 2);
    w.GATES = (float*)take((size_t)NTOK * 24 * 4);
    w.OA = (bf16_t*)take((size_t)NTOK * 512 * 2); w.OB = (bf16_t*)take((size_t)NTOK * 512 * 2);
    for (int j = 0; j < 2; ++j) w.CH[j] = (float*)take((size_t)4 * NCMP * 256 * 4);
    for (int j = 0; j < 2; ++j) w.CKV[j] = (bf16_t*)take((size_t)4 * NCP * 64 * 2);
    w.cnt = (int*)take(256); w.base = (int*)take(256);
    w.ltok = (int*)take((size_t)16 * NTOK * 4); w.lw = (float*)take((size_t)16 * NTOK * 4);
    w.CAT = (bf16_t*)w.ZT; w.HID2 = (bf16_t*)w.ZT; w.G = (float*)w.ZT;
    return w;
}

__global__ void k_rope_table(float* C, float* S) {
    const int i = blockIdx.x * blockDim.x + threadIdx.x; if (i >= SEQ * 32) return;
    const int pos = i >> 5, f = i & 31;
    double rev = (double)pos * ROPE_REV[f]; rev -= floor(rev);
    const float r = (float)rev;
    C[i] = __builtin_amdgcn_cosf(r); S[i] = __builtin_amdgcn_sinf(r);
}

__global__ void __launch_bounds__(256) k_rmsnorm_bf16(const float* __restrict__ X, const float* __restrict__ g, bf16_t* __restrict__ O, int rows) {
    const int row = blockIdx.x * 4 + (threadIdx.x >> 6), lane = threadIdx.x & 63; if (row >= rows) return;
    const float4* x = (const float4*)(X + (size_t)row * 1024); float4 v[4]; float s = 0.f;
#pragma unroll
    for (int i = 0; i < 4; ++i) { v[i] = x[lane + 64 * i]; s += v[i].x * v[i].x + v[i].y * v[i].y + v[i].z * v[i].z + v[i].w * v[i].w; }
    s = wave_sum(s); const float r = rsqrtf(s * (1.0f / 1024.0f) + EPS);
#pragma unroll
    for (int i = 0; i < 4; ++i) { const int c = (lane + 64 * i) * 4; const float4 gg = *(const float4*)(g + c);
        bf16_t* o = O + (size_t)row * 1024 + c; o[0] = f2bf(v[i].x * r * gg.x); o[1] = f2bf(v[i].y * r * gg.y); o[2] = f2bf(v[i].z * r * gg.z); o[3] = f2bf(v[i].w * r * gg.w); }
}

template <int NB, class AL, class EP>
__device__ __forceinline__ void gemm_tile(int m0, int n0, int M, int N, int K, AL aload, const float* B0, const float* B1, int ldb, EP epi) {
    __shared__ float sA[16][68]; __shared__ float sB[NB][16][68];
    const int tid = threadIdx.x, tx = tid & 15, ty = tid >> 4;
    float acc[NB][4][4];
#pragma unroll
    for (int b = 0; b < NB; ++b)
#pragma unroll
        for (int i = 0; i < 4; ++i)
#pragma unroll
            for (int j = 0; j < 4; ++j) acc[b][i][j] = 0.f;
    const int ar = tid >> 2, ak = (tid & 3) * 4;
    const int bk = tid >> 4, bn = (tid & 15) * 4;
    for (int k0 = 0; k0 < K; k0 += 16) {
        {
            const int row = m0 + ar;
#pragma unroll
            for (int j = 0; j < 4; ++j) sA[ak + j][ar] = (row < M) ? aload(row, k0 + ak + j) : 0.f;
#pragma unroll
            for (int b = 0; b < NB; ++b) { const float* Bp = b ? B1 : B0;
#pragma unroll
                for (int j = 0; j < 4; ++j) { const int col = n0 + bn + j; sB[b][bk][bn + j] = (col < N) ? Bp[(size_t)(k0 + bk) * ldb + col] : 0.f; } }
        }
        __syncthreads();
#pragma unroll
        for (int kk = 0; kk < 16; ++kk) {
            float a[4];
#pragma unroll
            for (int i = 0; i < 4; ++i) a[i] = sA[kk][ty * 4 + i];
#pragma unroll
            for (int b = 0; b < NB; ++b) { float bb[4];
#pragma unroll
                for (int j = 0; j < 4; ++j) bb[j] = sB[b][kk][tx * 4 + j];
#pragma unroll
                for (int i = 0; i < 4; ++i)
#pragma unroll
                    for (int j = 0; j < 4; ++j) acc[b][i][j] += a[i] * bb[j]; }
        }
        __syncthreads();
    }
#pragma unroll
    for (int i = 0; i < 4; ++i)
#pragma unroll
        for (int j = 0; j < 4; ++j) { const int row = m0 + ty * 4 + i, col = n0 + tx * 4 + j;
            if (row < M && col < N) { if (NB == 1) epi(row, col, acc[0][i][j], 0.f); else epi(row, col, acc[0][i][j], acc[NB - 1][i][j]); } }
}

__global__ void __launch_bounds__(256) k_gemm_in(const bf16_t* __restrict__ HN, const float* __restrict__ w_in, bf16_t* U, bf16_t* V, float* ZT) {
    const int m0 = blockIdx.y * 64, n0 = blockIdx.x * 64;
    gemm_tile<1>(m0, n0, NTOK, D_IN, D_MODEL,
        [&](int row, int k) { return bf2f(HN[(size_t)row * 1024 + k]); }, w_in, nullptr, D_IN,
        [&](int row, int col, float v, float) {
            if (col < 512) U[(size_t)row * 512 + col] = f2bf(gelu_tanh(v));
            else if (col < 1024) V[(size_t)row * 512 + col - 512] = f2bf(gelu_tanh(v));
            else ZT[(size_t)row * ZT_W + col - 1024] = v; });
}

__global__ void k_post_z(const float* __restrict__ ZT, const float* __restrict__ rC, const float* __restrict__ rS, bf16_t* Q, bf16_t* KV0, bf16_t* KV1, bf16_t* KV2, bf16_t* KV3, bf16_t* KV4, bf16_t* KV5, float* GATES) {
    const size_t idx = (size_t)blockIdx.x * blockDim.x + threadIdx.x; if (idx >= (size_t)NTOK * ZT_W) return;
    const int row = (int)(idx / ZT_W), c = (int)(idx % ZT_W); const int b = row / SEQ, t = row % SEQ;
    const float* z = ZT + (size_t)row * ZT_W;
    if (c < 512) {
        const int d = c & 63, i = d & 31; const float cs = rC[t * 32 + i], sn = rS[t * 32 + i];
        const float x1 = z[c - d + i], x2 = z[c - d + i + 32];
        const float o = (d < 32) ? (x1 * cs - x2 * sn) : (x1 * sn + x2 * cs);
        Q[(size_t)row * 512 + c] = f2bf(o * 0.125f);
    } else if (c < 512 + 768) {
        const int cc = c - 512, j = cc / 128, g = (cc % 128) / 64, d = cc & 63;
        bf16_t* dst = (j == 0 ? KV0 : j == 1 ? KV1 : j == 2 ? KV2 : j == 3 ? KV3 : j == 4 ? KV4 : KV5) + (((size_t)(b * 2 + g) * SEQ + t) * 64 + d);
        float o;
        if ((j & 1) == 0) { const int i = d & 31; const float cs = rC[t * 32 + i], sn = rS[t * 32 + i];
            const float x1 = z[c - d + i], x2 = z[c - d + i + 32]; o = (d < 32) ? (x1 * cs - x2 * sn) : (x1 * sn + x2 * cs); }
        else o = z[c];
        *dst = f2bf(o);
    } else { GATES[(size_t)row * 24 + (c - 1280)] = sigmoidf_(z[c]); }
}

__global__ void __launch_bounds__(256) k_gmlp(const bf16_t* __restrict__ U, const bf16_t* __restrict__ V, const float* __restrict__ g_v, const float* __restrict__ w_s, const float* __restrict__ b_s, bf16_t* OA) {
    __shared__ float vn[128][65]; __shared__ float rstd[128];
    const int g = blockIdx.x & 7, ch = blockIdx.x >> 3; const int tok0 = ch * 128; const int tid = threadIdx.x, lane = tid & 63, wv = tid >> 6;
    for (int r = wv; r < 128; r += 4) { const bf16_t* vr = V + (size_t)(tok0 + r) * 512; float s = 0.f;
        for (int c = lane; c < 512; c += 64) { const float x = bf2f(vr[c]); s += x * x; }
        s = wave_sum(s); if (lane == 0) rstd[r] = rsqrtf(s * (1.0f / 512.0f) + EPS); }
    __syncthreads();
    for (int i = tid; i < 128 * 64; i += 256) { const int r = i >> 6, d = i & 63; vn[r][d] = bf2f(V[(size_t)(tok0 + r) * 512 + g * 64 + d]) * rstd[r] * g_v[g * 64 + d]; }
    __syncthreads();
    const float* W = w_s + (size_t)g * 128 * 128;
    for (int t = wv; t < 128; t += 4) { float acc = 0.f; const float* wr = W + t * 128;
        for (int s = 0; s <= t; ++s) acc += wr[s] * vn[s][lane];
        acc += b_s[g * 128 + t];
        const size_t o = (size_t)(tok0 + t) * 512 + g * 64 + lane; OA[o] = f2bf(bf2f(U[o]) * acc); }
}

__global__ void __launch_bounds__(256) k_cmp1(const bf16_t* __restrict__ KX, const float* __restrict__ pe, const float* __restrict__ w1, float* H) {
    const int m0 = blockIdx.y * 64, n0 = blockIdx.x * 64;
    gemm_tile<1>(m0, n0, 4 * NCMP, 256, 2048,
        [&](int row, int k) { const int bg = row / NCMP, c = row % NCMP; return bf2f(KX[(size_t)bg * SEQ * 64 + (size_t)c * 16 * 64 + k]) + pe[k]; }, w1, nullptr, 256,
        [&](int row, int col, float v, float) { H[(size_t)row * 256 + col] = gelu_tanh(v); });
}
__global__ void __launch_bounds__(256) k_cmp2(const float* __restrict__ H, const float* __restrict__ w2, bf16_t* O) {
    const int m0 = blockIdx.y * 64, n0 = 0;
    gemm_tile<1>(m0, n0, 4 * NCMP, 64, 256,
        [&](int row, int k) { return H[(size_t)row * 256 + k]; }, w2, nullptr, 64,
        [&](int row, int col, float v, float) { const int bg = row / NCMP, c = row % NCMP; O[((size_t)bg * NCP + c) * 64 + col] = f2bf(v); });
}

__global__ void __launch_bounds__(256) k_attn(const bf16_t* __restrict__ Q, const bf16_t* __restrict__ CK, const bf16_t* __restrict__ CV, const bf16_t* __restrict__ KS, const bf16_t* __restrict__ VS,
                                               const bf16_t* __restrict__ KW, const bf16_t* __restrict__ VW, const float* __restrict__ GATES, bf16_t* OB) {
    __shared__ float qs[4][64]; __shared__ float sc[4][1024]; __shared__ float psum[512]; __shared__ float score[128]; __shared__ int sel[16];
    const int t = blockIdx.x % SEQ, bg = blockIdx.x / SEQ, b = bg >> 1, g = bg & 1; const int tid = threadIdx.x, lane = tid & 63, h = tid >> 6;
    const size_t tok = (size_t)b * SEQ + t;
    qs[h][lane] = bf2f(Q[tok * 512 + (g * 4 + h) * 64 + lane]);
    __syncthreads();
    const int ncv = (t >= 31) ? ((t - 31) / 16 + 1) : 0;
    const bf16_t* ck = CK + (size_t)bg * NCP * 64; const bf16_t* cv = CV + (size_t)bg * NCP * 64;
    for (int c = lane; c < ncv; c += 64) { float s = 0.f; const bf16_t* kr = ck + c * 64;
        for (int d = 0; d < 64; ++d) s += qs[h][d] * bf2f(kr[d]);
        sc[h][c] = s; }
    float o_c = 0.f;
    {
        float m = -1e30f; for (int c = lane; c < ncv; c += 64) m = fmaxf(m, sc[h][c]); m = wave_max(m);
        float l = 0.f; for (int c = lane; c < ncv; c += 64) { const float e = __expf(sc[h][c] - m); sc[h][c] = e; l += e; } l = wave_sum(l);
        const float inv = 1.0f / fmaxf(l, 1e-30f);
        for (int c = lane; c < ncv; c += 64) sc[h][c] *= inv;
    }
    __syncthreads();
    for (int c = 0; c < ncv; ++c) o_c += sc[h][c] * bf2f(cv[c * 64 + lane]);
    for (int c = tid; c < 512; c += 256) psum[c] = (c < ncv) ? (sc[0][c] + sc[1][c] + sc[2][c] + sc[3][c]) : 0.f;
    __syncthreads();
    const int cur = t >> 6;
    if (tid < 128) { const int s = tid; float imp = 0.f;
        for (int c = 4 * s - 1; c <= 4 * s + 3; ++c) if (c >= 0 && c < NCMP) imp += psum[c];
        const bool forced = (s == 0) || (s == cur) || (s == cur - 1); const bool valid = s <= cur;
        score[s] = forced ? 1e6f : (valid ? imp : -1e6f); }
    __syncthreads();
    if (tid < 128) { const int s = tid; const float v = score[s]; int r = 0;
        for (int j = 0; j < 128; ++j) { const float w = score[j]; r += (w > v || (w == v && j < s)) ? 1 : 0; }
        if (r < 16) sel[r] = s; }
    __syncthreads();
    const bf16_t* ks = KS + (size_t)bg * SEQ * 64; const bf16_t* vs = VS + (size_t)bg * SEQ * 64;
    for (int j = lane; j < 1024; j += 64) { const int pos = sel[j >> 6] * 64 + (j & 63); float s = -1e30f;
        if (pos <= t) { s = 0.f; const bf16_t* kr = ks + (size_t)pos * 64; for (int d = 0; d < 64; ++d) s += qs[h][d] * bf2f(kr[d]); }
        sc[h][j] = s; }
    float o_s = 0.f;
    {
        float m = -1e30f; for (int j = lane; j < 1024; j += 64) m = fmaxf(m, sc[h][j]); m = wave_max(m);
        float l = 0.f; for (int j = lane; j < 1024; j += 64) { const float s = sc[h][j]; const float e = (s > -1e29f) ? __expf(s - m) : 0.f; sc[h][j] = e; l += e; } l = wave_sum(l);
        const float inv = 1.0f / fmaxf(l, 1e-30f);
        for (int j = 0; j < 1024; ++j) { const float p = sc[h][j]; if (p != 0.f) { const int pos = sel[j >> 6] * 64 + (j & 63); o_s += p * bf2f(vs[(size_t)pos * 64 + lane]); } }
        o_s *= inv;
    }
    const bf16_t* kw = KW + (size_t)bg * SEQ * 64; const bf16_t* vw = VW + (size_t)bg * SEQ * 64;
    for (int j = lane; j < 512; j += 64) { const int pos = t - 511 + j; float s = -1e30f;
        if (pos >= 0) { s = 0.f; const bf16_t* kr = kw + (size_t)pos * 64; for (int d = 0; d < 64; ++d) s += qs[h][d] * bf2f(kr[d]); }
        sc[h][j] = s; }
    float o_w = 0.f;
    {
        float m = -1e30f; for (int j = lane; j < 512; j += 64) m = fmaxf(m, sc[h][j]); m = wave_max(m);
        float l = 0.f; for (int j = lane; j < 512; j += 64) { const float s = sc[h][j]; const float e = (s > -1e29f) ? __expf(s - m) : 0.f; sc[h][j] = e; l += e; } l = wave_sum(l);
        const float inv = 1.0f / fmaxf(l, 1e-30f);
        for (int j = 0; j < 512; ++j) { const float p = sc[h][j]; if (p != 0.f) { const int pos = t - 511 + j; o_w += p * bf2f(vw[(size_t)pos * 64 + lane]); } }
        o_w *= inv;
    }
    const float* gt = GATES + tok * 24 + (g * 4 + h) * 3;
    OB[tok * 512 + (g * 4 + h) * 64 + lane] = f2bf(gt[0] * o_c + gt[1] * o_s + gt[2] * o_w);
}

__global__ void __launch_bounds__(256) k_cat(const bf16_t* __restrict__ OA, const bf16_t* __restrict__ OB, const float* __restrict__ ga, const float* __restrict__ gb, bf16_t* CAT) {
    const int row = blockIdx.x * 4 + (threadIdx.x >> 6), lane = threadIdx.x & 63;
    float a[8], bb[8], sa = 0.f, sb = 0.f;
#pragma unroll
    for (int i = 0; i < 8; ++i) { a[i] = bf2f(OA[(size_t)row * 512 + lane + 64 * i]); bb[i] = bf2f(OB[(size_t)row * 512 + lane + 64 * i]); sa += a[i] * a[i]; sb += bb[i] * bb[i]; }
    sa = wave_sum(sa); sb = wave_sum(sb); const float ra = rsqrtf(sa * (1.0f / 512.0f) + EPS), rb = rsqrtf(sb * (1.0f / 512.0f) + EPS);
#pragma unroll
    for (int i = 0; i < 8; ++i) { const int c = lane + 64 * i; CAT[(size_t)row * 1024 + c] = f2bf(a[i] * ra * ga[c]); CAT[(size_t)row * 1024 + 512 + c] = f2bf(bb[i] * rb * gb[c]); }
}

__global__ void __launch_bounds__(256) k_gemm_wo(const bf16_t* __restrict__ CAT, const float* __restrict__ w_o, const float* __restrict__ X, float* OUT) {
    const int m0 = blockIdx.y * 64, n0 = blockIdx.x * 64;
    gemm_tile<1>(m0, n0, NTOK, 1024, 1024, [&](int row, int k) { return bf2f(CAT[(size_t)row * 1024 + k]); }, w_o, nullptr, 1024,
        [&](int row, int col, float v, float) { OUT[(size_t)row * 1024 + col] = X[(size_t)row * 1024 + col] + v; });
}

__global__ void __launch_bounds__(256) k_route(const float* __restrict__ H, const float* __restrict__ gmoe, const float* __restrict__ rg, const float* __restrict__ re, bf16_t* HN, int* cnt, int* ltok, float* lw) {
    const int row = blockIdx.x * 4 + (threadIdx.x >> 6), lane = threadIdx.x & 63;
    float x[16]; float s = 0.f;
#pragma unroll
    for (int i = 0; i < 16; ++i) { x[i] = H[(size_t)row * 1024 + lane + 64 * i]; s += x[i] * x[i]; }
    s = wave_sum(s); const float r = rsqrtf(s * (1.0f / 1024.0f) + EPS);
    float lg[20];
#pragma unroll
    for (int j = 0; j < 20; ++j) lg[j] = 0.f;
#pragma unroll
    for (int i = 0; i < 16; ++i) { const int c = lane + 64 * i; x[i] = x[i] * r * gmoe[c]; HN[(size_t)row * 1024 + c] = f2bf(x[i]);
#pragma unroll
        for (int j = 0; j < 4; ++j) lg[j] += x[i] * rg[c * 4 + j];
#pragma unroll
        for (int j = 0; j < 16; ++j) lg[4 + j] += x[i] * re[c * 16 + j]; }
#pragma unroll
    for (int j = 0; j < 20; ++j) lg[j] = wave_sum(lg[j]);
    if (lane == 0) {
        int gs = 0; float gm = lg[0];
        for (int j = 1; j < 4; ++j) if (lg[j] > gm) { gm = lg[j]; gs = j; }
        float den = 0.f; for (int j = 0; j < 4; ++j) den += __expf(lg[j] - gm); const float pg = 1.0f / den;
        float le[4];
#pragma unroll
        for (int j = 0; j < 4; ++j) le[j] = gs == 0 ? lg[4 + j] : gs == 1 ? lg[8 + j] : gs == 2 ? lg[12 + j] : lg[16 + j];
        float b0 = le[0]; int e0 = 0;
#pragma unroll
        for (int j = 1; j < 4; ++j) if (le[j] > b0) { b0 = le[j]; e0 = j; }
        float b1 = -3.0e38f; int e1 = -1;
#pragma unroll
        for (int j = 0; j < 4; ++j) if (j != e0 && (e1 < 0 || le[j] > b1)) { b1 = le[j]; e1 = j; }
        const float p1 = __expf(b1 - b0);
        const float w0 = pg / (1.0f + p1), w1 = pg * p1 / (1.0f + p1);
        const int E0 = gs * 4 + e0, E1 = gs * 4 + e1;
        int s0 = atomicAdd(cnt + E0, 1); ltok[E0 * NTOK + s0] = row; lw[E0 * NTOK + s0] = w0;
        int s1 = atomicAdd(cnt + E1, 1); ltok[E1 * NTOK + s1] = row; lw[E1 * NTOK + s1] = w1;
    }
}
__global__ void k_base(const int* cnt, int* base) { if (threadIdx.x == 0) { int a = 0; for (int e = 0; e < 16; ++e) { base[e] = a; a += cnt[e]; } } }

__global__ void __launch_bounds__(256) k_moe1(const bf16_t* __restrict__ HN, const float* __restrict__ wg, const float* __restrict__ wu, const int* __restrict__ cnt, const int* __restrict__ base, const int* __restrict__ ltok, bf16_t* HID2) {
    const int e = blockIdx.z, M = cnt[e]; const int m0 = blockIdx.y * 64, n0 = blockIdx.x * 64; if (m0 >= M) return;
    const int* lt = ltok + e * NTOK; const int bs = base[e];
    gemm_tile<2>(m0, n0, M, 512, 1024, [&](int row, int k) { return bf2f(HN[(size_t)lt[row] * 1024 + k]); }, wg + (size_t)e * 1024 * 512, wu + (size_t)e * 1024 * 512, 512,
        [&](int row, int col, float a, float u) { HID2[(size_t)(bs + row) * 512 + col] = f2bf(a * sigmoidf_(a) * u); });
}
__global__ void __launch_bounds__(256) k_moe2(const bf16_t* __restrict__ HID2, const float* __restrict__ wd, const int* __restrict__ cnt, const int* __restrict__ base, const int* __restrict__ ltok, const float* __restrict__ lw, float* OUT) {
    const int e = blockIdx.z, M = cnt[e]; const int m0 = blockIdx.y * 64, n0 = blockIdx.x * 64; if (m0 >= M) return;
    const int* lt = ltok + e * NTOK; const float* ww = lw + e * NTOK; const int bs = base[e];
    gemm_tile<1>(m0, n0, M, 1024, 512, [&](int row, int k) { return bf2f(HID2[(size_t)(bs + row) * 512 + k]); }, wd + (size_t)e * 512 * 1024, nullptr, 1024,
        [&](int row, int col, float v, float) { atomicAdd(OUT + (size_t)lt[row] * 1024 + col, ww[row] * v); });
}

__global__ void __launch_bounds__(256) k_ple_gate(const bf16_t* __restrict__ HN, const float* __restrict__ wpg, float* G) {
    const int m0 = blockIdx.y * 64, n0 = blockIdx.x * 64;
    gemm_tile<1>(m0, n0, NTOK, 1024, 1024, [&](int row, int k) { return bf2f(HN[(size_t)row * 1024 + k]); }, wpg, nullptr, 1024,
        [&](int row, int col, float v, float) { G[(size_t)row * 1024 + col] = v; });
}
__global__ void __launch_bounds__(256) k_ple_proj(const float* __restrict__ P, const float* __restrict__ wpe, const float* __restrict__ G, float* OUT) {
    const int m0 = blockIdx.y * 64, n0 = blockIdx.x * 64;
    gemm_tile<1>(m0, n0, NTOK, 1024, 256, [&](int row, int k) { return P[(size_t)row * 256 + k]; }, wpe, nullptr, 1024,
        [&](int row, int col, float v, float) { const size_t o = (size_t)row * 1024 + col; OUT[o] = OUT[o] + v * sigmoidf_(G[o]); });
}
__global__ void __launch_bounds__(256) k_final(float* OUT, const float* __restrict__ g) {
    const int row = blockIdx.x * 4 + (threadIdx.x >> 6), lane = threadIdx.x & 63;
    float4* x = (float4*)(OUT + (size_t)row * 1024); float4 v[4]; float s = 0.f;
#pragma unroll
    for (int i = 0; i < 4; ++i) { v[i] = x[lane + 64 * i]; s += v[i].x * v[i].x + v[i].y * v[i].y + v[i].z * v[i].z + v[i].w * v[i].w; }
    s = wave_sum(s); const float r = rsqrtf(s * (1.0f / 1024.0f) + EPS);
#pragma unroll
    for (int i = 0; i < 4; ++i) { const float4 gg = *(const float4*)(g + (lane + 64 * i) * 4); x[lane + 64 * i] = make_float4(v[i].x * r * gg.x, v[i].y * r * gg.y, v[i].z * r * gg.z, v[i].w * r * gg.w); }
}

extern "C" void kernel_launch(void* const* d_in, const int* in_sizes, int n_in, void* d_out, int out_size, void* d_ws, size_t ws_size, hipStream_t stream) {
    const float* x = (const float*)d_in[0]; const float* p = (const float*)d_in[1]; const float* norm_mix = (const float*)d_in[2]; const float* w_in = (const float*)d_in[3];
    const float* g_v = (const float*)d_in[4]; const float* w_s = (const float*)d_in[5]; const float* b_s = (const float*)d_in[6];
    const float* pe_k = (const float*)d_in[7]; const float* w1_k = (const float*)d_in[8]; const float* w2_k = (const float*)d_in[9];
    const float* pe_v = (const float*)d_in[10]; const float* w1_v = (const float*)d_in[11]; const float* w2_v = (const float*)d_in[12];
    const float* g_a = (const float*)d_in[13]; const float* g_b = (const float*)d_in[14]; const float* w_o = (const float*)d_in[15];
    const float* norm_moe = (const float*)d_in[16]; const float* r_g = (const float*)d_in[17]; const float* r_e = (const float*)d_in[18];
    const float* wg = (const float*)d_in[19]; const float* wu = (const float*)d_in[20]; const float* wd = (const float*)d_in[21];
    const float* norm_ple = (const float*)d_in[22]; const float* w_pe = (const float*)d_in[23]; const float* w_pg = (const float*)d_in[24]; const float* norm_final = (const float*)d_in[25];
    float* out = (float*)d_out;
    WS w = make_ws(d_ws);
    hipMemsetAsync(w.cnt, 0, 256, stream);
    k_rope_table<<<SEQ * 32 / 256, 256, 0, stream>>>(w.ropeC, w.ropeS);
    k_rmsnorm_bf16<<<NTOK / 4, 256, 0, stream>>>(x, norm_mix, w.HN, NTOK);
    k_gemm_in<<<dim3((D_IN + 63) / 64, NTOK / 64), 256, 0, stream>>>(w.HN, w_in, w.U, w.V, w.ZT);
    k_post_z<<<(unsigned)(((size_t)NTOK * ZT_W + 255) / 256), 256, 0, stream>>>(w.ZT, w.ropeC, w.ropeS, w.Q, w.KV[0], w.KV[1], w.KV[2], w.KV[3], w.KV[4], w.KV[5], w.GATES);
    k_gmlp<<<(NTOK / 128) * 8, 256, 0, stream>>>(w.U, w.V, g_v, w_s, b_s, w.OA);
    k_cmp1<<<dim3(4, (4 * NCMP + 63) / 64), 256, 0, stream>>>(w.KV[0], pe_k, w1_k, w.CH[0]);
    k_cmp1<<<dim3(4, (4 * NCMP + 63) / 64), 256, 0, stream>>>(w.KV[1], pe_v, w1_v, w.CH[1]);
    k_cmp2<<<dim3(1, (4 * NCMP + 63) / 64), 256, 0, stream>>>(w.CH[0], w2_k, w.CKV[0]);
    k_cmp2<<<dim3(1, (4 * NCMP + 63) / 64), 256, 0, stream>>>(w.CH[1], w2_v, w.CKV[1]);
    k_attn<<<4 * SEQ, 256, 0, stream>>>(w.Q, w.CKV[0], w.CKV[1], w.KV[2], w.KV[3], w.KV[4], w.KV[5], w.GATES, w.OB);
    k_cat<<<NTOK / 4, 256, 0, stream>>>(w.OA, w.OB, g_a, g_b, w.CAT);
    k_gemm_wo<<<dim3(16, NTOK / 64), 256, 0, stream>>>(w.CAT, w_o, x, out);
    k_route<<<NTOK / 4, 256, 0, stream>>>(out, norm_moe, r_g, r_e, w.HN, w.cnt, w.ltok, w.lw);
    k_base<<<1, 64, 0, stream>>>(w.cnt, w.base);
    k_moe1<<<dim3(8, NTOK / 64, 16), 256, 0, stream>>>(w.HN, wg, wu, w.cnt, w.base, w.ltok, w.HID2);
    k_moe2<<<dim3(16, NTOK / 64, 16), 256, 0, stream>>>(w.HID2, wd, w.cnt, w.base, w.ltok, w.lw, out);
    k_rmsnorm_bf16<<<NTOK / 4, 256, 0, stream>>>(out, norm_ple, w.HN, NTOK);
    k_ple_gate<<<dim3(16, NTOK / 64), 256, 0, stream>>>(w.HN, w_pg, w.G);
    k_ple_proj<<<dim3(16, NTOK / 64), 256, 0, stream>>>(p, w_pe, w.G, out);
    k_final<<<NTOK / 4, 256, 0, stream>>>(out, norm_final);
}
```

```cpp
#include <hip/hip_runtime.h>
#include <cstdint>
#include <cstdio>

constexpr int D_MODEL = 1024, BATCH = 2, SEQ = 8192, NTOK = BATCH * SEQ;
constexpr int HD = 64, A_WIDTH = 512, B_WIDTH = 512, B_KV = 2, KV_W = 128;
constexpr int N_GATES = 24, CHUNK = 128, L_CMP = 32, STRIDE_CMP = 16, CMP_HIDDEN = 256;
constexpr int L_SEL = 64, N_SEL = 16, WIN = 512, NCMP = 511, NCP = 512, NSB = 128;
constexpr int N_EXPERTS = 16, D_FF = 512, D_PLE = 256;
constexpr int OFF_Q = 1024, OFF_KV = 1536, OFF_GATE = 2304, D_IN = 2328;
constexpr int N_IN_PAD = 2560;
constexpr float EPS = 1e-6f;

typedef unsigned short bf16_t;
__device__ __forceinline__ bf16_t f2bf(float f) { unsigned u = __float_as_uint(f); u += 0x7fffu + ((u >> 16) & 1u); return (bf16_t)(u >> 16); }
__device__ __forceinline__ float bf2f(bf16_t h) { return __uint_as_float(((unsigned)h) << 16); }
__device__ __forceinline__ unsigned pk2(float lo, float hi) { return (unsigned)f2bf(lo) | ((unsigned)f2bf(hi) << 16); }
__device__ __forceinline__ float gelu_tanh(float x) { const float u = 0.7978845608028654f * (x + 0.044715f * x * x * x); return 0.5f * x * (1.0f + tanhf(u)); }
__device__ __forceinline__ float gelu_fast(float x) { const float u = x * (0.7978845608028654f + 0.035677408136300125f * x * x); return x * __builtin_amdgcn_rcpf(1.0f + __builtin_amdgcn_exp2f(-2.8853900817779268f * u)); }
__device__ __forceinline__ float sigmoidf_(float x) { return 1.0f / (1.0f + __expf(-x)); }
__device__ __forceinline__ float wave_sum(float v) {
#pragma unroll
    for (int o = 32; o > 0; o >>= 1) v += __shfl_xor(v, o);
    return v;
}
__device__ __forceinline__ float wave_max(float v) {
#pragma unroll
    for (int o = 32; o > 0; o >>= 1) v = fmaxf(v, __shfl_xor(v, o));
    return v;
}

__device__ const double ROPE_REV[32] = {0.15915494309189535, 0.11934937021124886, 0.08949940160889101, 0.06711508300522726, 0.050329212104487035, 0.03774158471741977, 0.0283021958306234, 0.02122365276477766, 0.015915494309189534, 0.011934937021124886, 0.008949940160889102, 0.006711508300522725, 0.005032921210448704, 0.003774158471741977, 0.00283021958306234, 0.0021223652764777662, 0.0015915494309189536, 0.0011934937021124885, 0.0008949940160889102, 0.0006711508300522726, 0.0005032921210448703, 0.00037741584717419774, 0.00028302195830623395, 0.0002122365276477766, 0.00015915494309189535, 0.00011934937021124886, 8.949940160889102e-05, 6.711508300522725e-05, 5.0329212104487035e-05, 3.774158471741978e-05, 2.8302195830623396e-05, 2.122365276477766e-05};

namespace pg8 {
#define PG8_LAS __attribute__((address_space(3)))
typedef unsigned short bf16_t;
typedef short bf16x8 __attribute__((ext_vector_type(8)));
typedef float f32x4 __attribute__((ext_vector_type(4)));
typedef unsigned u32x4 __attribute__((ext_vector_type(4)));
constexpr int BM = 256, BK = 64, HALF = 128, HTB = HALF * BK * 2  , STAGE_BYTES = 8 * HTB, NXCD = 8, WGM = 8;

__host__ __device__ __forceinline__ int lds_byte(int r, int c) { const int st = (r >> 4) * 2 + (c >> 5), rr = r & 15, cc = c & 31, ob = rr * 64 + cc * 2; return st * 1024 + (ob ^ (((ob >> 9) & 1) << 5)); }
__host__ __device__ __forceinline__ void stage_rc(int b, int& R, int& C) { const int st = b / 1024, sb = b % 1024, swz = sb ^ (((sb >> 9) & 1) << 5); R = (st >> 1) * 16 + swz / 64; C = (st & 1) * 32 + (swz % 64) / 2; }
__host__ __device__ __forceinline__ int perm32(int rho) { const int n = rho >> 4, i = rho & 15; return 8 * (i >> 2) + 4 * n + (i & 3); }

struct Unit { int pm, pn; };
struct Gemm { const bf16_t* A; const bf16_t* Bt; int M, N, K, lda, ldb; const int* rowmap; };

struct StaticOrder {
    int nM, nN, nwg, G, c;
    __host__ __device__ void init(int M, int N, int G_, int c_) { nM = M / BM; nN = N / BM; nwg = nM * nN; G = G_; c = c_; }
    __host__ __device__ bool next(int i, Unit& u) const {
        const long L = (long)i * G + c; if (L >= nwg) return false;
        int wgid = (int)L; { const int q = nwg / NXCD, r = nwg % NXCD, xcd = wgid % NXCD, off = wgid / NXCD; wgid = (xcd < r ? xcd * (q + 1) : r * (q + 1) + (xcd - r) * q) + off; }
        const int nig = WGM * nN, gid = wgid / nig, fm = gid * WGM, gsz = (nM - fm) < WGM ? (nM - fm) : WGM;
        u.pm = fm + ((wgid % nig) % gsz); u.pn = (wgid % nig) / gsz; return true;
    }
    __device__ __forceinline__ void a_ready(const Unit&) const {}
    __device__ __forceinline__ void done(const Unit&) const {}
};

template <class Epi, class Sched, bool ALIGN_EPI = false, bool SP2 = false, bool GATHER = false>
__device__ __forceinline__ void gemm_phase(PG8_LAS unsigned char* lds, const Gemm g, const Sched& S, const Epi& E) {
    const int tid = threadIdx.x, wid = __builtin_amdgcn_readfirstlane(tid >> 6), lane = tid & 63, wr = wid >> 2, wc = wid & 3, fr = lane & 15, fq = lane >> 4;
    const int K = g.K, nt = K / BK;
    unsigned voffA[2], voffB[2];
#pragma unroll
    for (int i = 0; i < 2; ++i) { int R, C; stage_rc(tid * 16 + i * 8192, R, C); const int Rb = Epi::PERM ? ((R & ~31) + perm32(R & 31)) : R;
        voffA[i] = (unsigned)(R * g.lda + C) * 2u; voffB[i] = (unsigned)(Rb * g.ldb + C) * 2u; }
    int gR0 = 0, gR1 = 0, gC0 = 0, gC1 = 0; { int R, C; stage_rc(tid * 16, R, C); gR0 = R; gC0 = C; stage_rc(tid * 16 + 8192, R, C); gR1 = R; gC1 = C; }
    unsigned vgc00 = 0, vgc01 = 0, vgc10 = 0, vgc11 = 0, vgn00 = 0, vgn01 = 0, vgn10 = 0, vgn11 = 0;
#define PG8_LOADVG(u, v00, v01, v10, v11) do { const int* rm_ = g.rowmap + (u).pm * BM; \
        v00 = (unsigned)(rm_[gR0] * g.lda + gC0) * 2u; v01 = (unsigned)(rm_[gR1] * g.lda + gC1) * 2u; \
        v10 = (unsigned)(rm_[HALF + gR0] * g.lda + gC0) * 2u; v11 = (unsigned)(rm_[HALF + gR1] * g.lda + gC1) * 2u; \
        asm volatile("" : "+v"(v00), "+v"(v01), "+v"(v10), "+v"(v11)); } while (0)
#define PG8_STA(b, h, ptr, nextflag) do { if constexpr (GATHER) { unsigned vs_[2]; \
        vs_[0] = (nextflag) ? ((h) ? vgn10 : vgn00) : ((h) ? vgc10 : vgc00); vs_[1] = (nextflag) ? ((h) ? vgn11 : vgn01) : ((h) ? vgc11 : vgc01); \
        PG8_STAGE(PG8_SA(b, h), ptr, vs_); } else { PG8_STAGE(PG8_SA(b, h), (ptr) + ((h) ? hstepA : 0), voffA); } } while (0)
    const size_t kstep = (size_t)(BK * 2);
    const size_t hstepA = (size_t)HALF * g.lda * 2, hstepB = (size_t)HALF * g.ldb * 2;
    const size_t tstepA = 2 * hstepA, tstepB = 2 * hstepB;
    const unsigned ldsw = (unsigned)wid * 1024u;
    const int aoff = lds_byte(wr * 64 + fr, fq * 8), boff = lds_byte(wc * 32 + fr, fq * 8);
#define PG8_SA(b, h) (((b) * 2 + (h)) * HTB)
#define PG8_SB(b, h) ((4 + (b) * 2 + (h)) * HTB)
#define PG8_STAGE(bufoff, gbase, voff) do { _Pragma("unroll") for (int _i = 0; _i < 2; ++_i) \
        __builtin_amdgcn_global_load_lds((const unsigned*)((const char*)(gbase) + (voff)[_i]), (PG8_LAS unsigned*)(lds + (bufoff) + ldsw + _i * 8192), 16, 0, 0); } while (0)
#define PG8_LDA(dst, b, h) do { _Pragma("unroll") for (int m = 0; m < 4; ++m) _Pragma("unroll") for (int k = 0; k < 2; ++k) dst[m][k] = *(const PG8_LAS bf16x8*)(lds + PG8_SA(b, h) + aoff + m * 2048 + k * 1024); } while (0)
#define PG8_LDB(dst, b, h) do { _Pragma("unroll") for (int n = 0; n < 2; ++n) _Pragma("unroll") for (int k = 0; k < 2; ++k) dst[n][k] = *(const PG8_LAS bf16x8*)(lds + PG8_SB(b, h) + boff + n * 2048 + k * 1024); } while (0)
#define PG8_MMA(ai, bj, At, Bt) do { __builtin_amdgcn_s_setprio(1); _Pragma("unroll") for (int m = 0; m < 4; ++m) _Pragma("unroll") for (int n = 0; n < 2; ++n) _Pragma("unroll") for (int k = 0; k < 2; ++k) \
        acc[ai][bj][m][n] = __builtin_amdgcn_mfma_f32_16x16x32_bf16(Bt[n][k], At[m][k], acc[ai][bj][m][n], 0, 0, 0); __builtin_amdgcn_s_setprio(0); } while (0)
#define PG8_WAIT_V(n) asm volatile("s_waitcnt vmcnt(" #n ")" ::: "memory")
#define PG8_WAIT_L(n) asm volatile("s_waitcnt lgkmcnt(" #n ")" ::: "memory")
#define PG8_BAR __builtin_amdgcn_s_barrier()
#define PG8_SCHED __builtin_amdgcn_sched_barrier(0)
    Unit cur, nxt; int ui = 0;
    if (!S.next(0, cur)) return;
    f32x4 acc[2][2][4][2];
#pragma unroll
    for (int a = 0; a < 2; ++a)
#pragma unroll
        for (int b = 0; b < 2; ++b)
#pragma unroll
            for (int m = 0; m < 4; ++m)
#pragma unroll
                for (int n = 0; n < 2; ++n) acc[a][b][m][n] = (f32x4){0.f, 0.f, 0.f, 0.f};
    bf16x8 At[4][2], B0[2][2], B1[2][2];
    const char* cA = (const char*)g.A + (GATHER ? (size_t)0 : (size_t)cur.pm * tstepA); const char* cB = (const char*)g.Bt + (size_t)cur.pn * tstepB;
    if constexpr (GATHER) PG8_LOADVG(cur, vgc00, vgc01, vgc10, vgc11);
    S.a_ready(cur);
    if constexpr (SP2) {
        PG8_STAGE(PG8_SB(0, 0), cB, voffB); PG8_STAGE(PG8_SB(0, 1), cB + hstepB, voffB); PG8_STA(0, 0, cA, false); PG8_STA(0, 1, cA, false);
        if (wr == 1) PG8_BAR;
        PG8_WAIT_V(2); PG8_BAR;
        PG8_STAGE(PG8_SB(1, 0), cB + kstep, voffB); PG8_STA(1, 0, cA + kstep, false); PG8_STAGE(PG8_SB(1, 1), cB + hstepB + kstep, voffB);
        PG8_WAIT_V(6); PG8_BAR;
    } else {
        PG8_STAGE(PG8_SB(0, 0), cB, voffB); PG8_STA(0, 0, cA, false); PG8_STAGE(PG8_SB(0, 1), cB + hstepB, voffB); PG8_STA(0, 1, cA, false);
        if (wr == 1) PG8_BAR;
        PG8_WAIT_V(4); PG8_BAR;
        PG8_STAGE(PG8_SB(1, 0), cB + kstep, voffB); PG8_STA(1, 0, cA + kstep, false); PG8_STAGE(PG8_SB(1, 1), cB + hstepB + kstep, voffB);
        PG8_WAIT_V(6); PG8_BAR;
    }
    for (;;) {
        const bool has_next = S.next(ui + 1, nxt);
        const char* nA = (has_next && !GATHER) ? (const char*)g.A + (size_t)nxt.pm * tstepA : cA; const char* nB = has_next ? (const char*)g.Bt + (size_t)nxt.pn * tstepB : cB;
        if constexpr (GATHER) { if (has_next) PG8_LOADVG(nxt, vgn00, vgn01, vgn10, vgn11); else { vgn00 = vgc00; vgn01 = vgc01; vgn10 = vgc10; vgn11 = vgc11; } }
        for (int t = 0; t < nt; t += 2) {
            const bool last = (t == nt - 2);
            const char* a1 = cA + (size_t)(t + 1) * kstep;
            const char* a2 = last ? nA : cA + (size_t)(t + 2) * kstep; const char* b2 = last ? nB : cB + (size_t)(t + 2) * kstep;
            const char* a3 = a2 + kstep; const char* b3 = b2 + kstep;
            if (last && has_next) S.a_ready(nxt);
            if constexpr (SP2) {
            PG8_LDB(B0, 0, 0); PG8_LDB(B1, 0, 1); PG8_SCHED; PG8_LDA(At, 0, 0); PG8_STA(1, 1, a1, false);
            PG8_WAIT_V(8); PG8_WAIT_L(0); PG8_BAR; PG8_MMA(0, 0, At, B0); PG8_MMA(0, 1, At, B1); PG8_BAR; PG8_SCHED;
            PG8_LDA(At, 0, 1); PG8_STAGE(PG8_SB(0, 0), b2, voffB); PG8_STAGE(PG8_SB(0, 1), b2 + hstepB, voffB); PG8_STA(0, 0, a2, last);
            PG8_WAIT_V(8); PG8_WAIT_L(0); PG8_BAR; PG8_MMA(1, 0, At, B0); PG8_MMA(1, 1, At, B1); PG8_BAR; PG8_SCHED;
            PG8_LDB(B0, 1, 0); PG8_LDB(B1, 1, 1); PG8_SCHED; PG8_LDA(At, 1, 0); PG8_STA(0, 1, a2, last);
            PG8_WAIT_V(8); PG8_WAIT_L(0); PG8_BAR; PG8_MMA(0, 0, At, B0); PG8_MMA(0, 1, At, B1); PG8_BAR; PG8_SCHED;
            PG8_LDA(At, 1, 1); PG8_STAGE(PG8_SB(1, 0), b3, voffB); PG8_STAGE(PG8_SB(1, 1), b3 + hstepB, voffB); PG8_STA(1, 0, a3, last);
            PG8_WAIT_V(8); PG8_WAIT_L(0); PG8_BAR; PG8_MMA(1, 0, At, B0); PG8_MMA(1, 1, At, B1); PG8_BAR; PG8_SCHED;
            } else {
            PG8_LDB(B0, 0, 0); PG8_SCHED; PG8_LDA(At, 0, 0); PG8_STA(1, 1, a1, false);
            PG8_WAIT_L(8); PG8_BAR; PG8_WAIT_L(0); PG8_MMA(0, 0, At, B0); PG8_BAR; PG8_SCHED;
            PG8_LDB(B1, 0, 1); PG8_STAGE(PG8_SB(0, 0), b2, voffB);
            PG8_BAR; PG8_WAIT_L(0); PG8_MMA(0, 1, At, B1); PG8_BAR;
            PG8_LDA(At, 0, 1); PG8_STA(0, 0, a2, last);
            PG8_BAR; PG8_WAIT_L(0); PG8_MMA(1, 0, At, B0); PG8_BAR; PG8_SCHED;
            PG8_STAGE(PG8_SB(0, 1), b2 + hstepB, voffB);
            PG8_WAIT_V(6); PG8_BAR; PG8_MMA(1, 1, At, B1); PG8_BAR;
            PG8_LDB(B0, 1, 0); PG8_SCHED; PG8_LDA(At, 1, 0); PG8_STA(0, 1, a2, last);
            PG8_WAIT_L(8); PG8_BAR; PG8_WAIT_L(0); PG8_MMA(0, 0, At, B0); PG8_BAR; PG8_SCHED;
            PG8_LDB(B1, 1, 1); PG8_STAGE(PG8_SB(1, 0), b3, voffB);
            PG8_BAR; PG8_WAIT_L(0); PG8_MMA(0, 1, At, B1); PG8_BAR;
            PG8_LDA(At, 1, 1); PG8_STA(1, 0, a3, last);
            PG8_BAR; PG8_WAIT_L(0); PG8_MMA(1, 0, At, B0); PG8_BAR; PG8_SCHED;
            PG8_STAGE(PG8_SB(1, 1), b3 + hstepB, voffB);
            PG8_WAIT_V(6); PG8_BAR; PG8_MMA(1, 1, At, B1); PG8_BAR;
            }
        }
        if constexpr (ALIGN_EPI) { if (wr == 0) PG8_BAR; }
        if constexpr (!Epi::AFTER_DRAIN) { E(acc, cur, wr, wc, fr, fq); S.done(cur); }
        if (!has_next) break;
#pragma unroll
        for (int a = 0; a < 2; ++a)
#pragma unroll
            for (int b = 0; b < 2; ++b)
#pragma unroll
                for (int m = 0; m < 4; ++m)
#pragma unroll
                    for (int n = 0; n < 2; ++n) acc[a][b][m][n] = (f32x4){0.f, 0.f, 0.f, 0.f};
        cur = nxt; cA = nA; cB = nB; ++ui; if constexpr (GATHER) { vgc00 = vgn00; vgc01 = vgn01; vgc10 = vgn10; vgc11 = vgn11; }
        if constexpr (ALIGN_EPI) { if (wr == 1) PG8_BAR; }
    }
    PG8_WAIT_V(0);
    if constexpr (!ALIGN_EPI) { if (wr == 0) PG8_BAR; }
    PG8_BAR;
    if constexpr (Epi::AFTER_DRAIN) { E.fused(acc, cur, wr, wc, fr, fq, lds, wid, lane); S.done(cur); }
#undef PG8_SA
#undef PG8_SB
#undef PG8_STAGE
#undef PG8_LDA
#undef PG8_LDB
#undef PG8_MMA
#undef PG8_WAIT_V
#undef PG8_WAIT_L
#undef PG8_BAR
#undef PG8_SCHED
#undef PG8_STA
#undef PG8_LOADVG
}
}

#define GAS __attribute__((address_space(1)))
#define LAS __attribute__((address_space(3)))
#define XB_TMO      128
#define XB_XCNT(j)  (256  + 64 * (j))
#define XB_XSUB(j)  (1280 + 64 * (j))
#define XB_XGEN(j)  (2304 + 64 * (j))
#define XB_TOP      3328
#define XB_TOPGEN   3392
#define XCD_BAR_WORDS 3456
#define XB_SPIN_CAP (1u << 18)

__device__ __forceinline__ unsigned xb_ld(unsigned* p)              { return __hip_atomic_load(p, __ATOMIC_RELAXED, __HIP_MEMORY_SCOPE_AGENT); }
__device__ __forceinline__ unsigned xb_add(unsigned* p, unsigned v) { return __hip_atomic_fetch_add(p, v, __ATOMIC_RELAXED, __HIP_MEMORY_SCOPE_AGENT); }
__device__ __forceinline__ unsigned xb_xcc_id() { return (unsigned)__builtin_amdgcn_s_getreg((3 << 11) | 20) & 0xFu; }
#define XB_SPIN(cond, bar) do { unsigned _sp = 0; while (cond) { __builtin_amdgcn_s_sleep(1); \
    if ((++_sp & 255u) == 0u) { if (xb_ld(&(bar)[XB_TMO])) break; if (_sp > XB_SPIN_CAP) { atomicAdd(&(bar)[XB_TMO], 1u); break; } } } } while (0)

struct XcdBarrier {
    unsigned* bar; unsigned x;
    volatile LAS unsigned* st;
};

__device__ __forceinline__ XcdBarrier xcd_barrier_post(unsigned* bar, volatile LAS unsigned* st) {
    XcdBarrier b; b.bar = bar; b.x = xb_xcc_id(); b.st = st;
    if (threadIdx.x == 0) (void)xb_add(&bar[XB_XCNT(b.x)], 1u);
    return b;
}
__device__ __forceinline__ void xcd_barrier_complete(unsigned* bar, unsigned x, unsigned& nloc, unsigned& nx) {
    const unsigned G = gridDim.x * gridDim.y * gridDim.z;
    unsigned sum, cnt, mine, sp = 0u;
    for (;;) {
        sum = 0u; cnt = 0u; mine = 0u;
#pragma unroll
        for (unsigned j = 0; j < 16; ++j) { const unsigned c = xb_ld(&bar[XB_XCNT(j)]); sum += c; cnt += (c > 0u) ? 1u : 0u; mine = (j == x) ? c : mine; }
        if (sum == G) break;
        __builtin_amdgcn_s_sleep(1);
        if ((++sp & 255u) == 0u) { if (xb_ld(&bar[XB_TMO])) break; if (sp > XB_SPIN_CAP) { atomicAdd(&bar[XB_TMO], 1u); break; } }
    }
    nloc = mine > 0u ? mine : 1u; nx = cnt > 0u ? cnt : 1u;
}

__device__ __forceinline__ void xcd_barrier(const XcdBarrier& b) {
    asm volatile("s_waitcnt vmcnt(0)" ::: "memory");
    __syncthreads();
    if (threadIdx.x == 0) {
        unsigned* bar = b.bar;
        __builtin_amdgcn_s_waitcnt(0);
        unsigned nloc = b.st[0], nx = b.st[1];
        if (nloc == 0u) { xcd_barrier_complete(bar, b.x, nloc, nx); b.st[0] = nloc; b.st[1] = nx; }
        const unsigned old = xb_add(&bar[XB_XSUB(b.x)], 1u);
        const unsigned gen = old / nloc;
        if (old + 1u == (gen + 1u) * nloc) {
            __builtin_amdgcn_fence(__ATOMIC_RELEASE, "agent");
            asm volatile("s_waitcnt vmcnt(0)" ::: "memory");
            const unsigned og = xb_add(&bar[XB_TOP], 1u);
            const unsigned tg = og / nx;
            if (og + 1u == (tg + 1u) * nx) xb_add(&bar[XB_TOPGEN], 1u);
            else XB_SPIN(xb_ld(&bar[XB_TOPGEN]) == tg, bar);
            __builtin_amdgcn_fence(__ATOMIC_ACQUIRE, "agent");
            xb_add(&bar[XB_XGEN(b.x)], 1u);
            asm volatile("s_waitcnt vmcnt(0)" ::: "memory");
        } else {
            XB_SPIN(xb_ld(&bar[XB_XGEN(b.x)]) == gen, bar);
            __builtin_amdgcn_fence(__ATOMIC_ACQUIRE, "agent");
            asm volatile("s_waitcnt vmcnt(0)" ::: "memory");
        }
    }
    __syncthreads();
}

constexpr size_t MiB = 1u << 20, KiB = 1u << 10;
constexpr size_t WS_CTL = 0, CTL_ZERO_BYTES = 1 * MiB;
constexpr size_t WS_ROPEC = 1 * MiB, WS_ROPES = 2 * MiB;
constexpr size_t WS_WT_IN = 3 * MiB;
constexpr size_t WS_HN = 8 * MiB;
constexpr size_t WS_U = 40 * MiB, WS_V = 56 * MiB, WS_Q = 72 * MiB;
constexpr size_t WS_KV = 88 * MiB, KV_STRIDE = 4 * MiB;
constexpr size_t WS_CAT = 114 * MiB;
constexpr size_t WS_YS = 40 * MiB;
constexpr size_t WS_GATES = 112 * MiB;
constexpr size_t WS_OB = 8 * MiB;
constexpr size_t WS_PBF = 114 * MiB;
constexpr size_t WS_HID = 114 * MiB;
constexpr size_t WS_CK = 152 * MiB, WS_CV = 153 * MiB;
constexpr size_t WS_ROUTE = 154 * MiB;
constexpr size_t WS_VSQ = 155 * MiB;
constexpr size_t WS_W1T = 157 * MiB;
constexpr size_t WS_W2T = 159 * MiB;
constexpr size_t WS_CBIAS = 159 * MiB + 128 * KiB;
constexpr size_t WS_WTRI = 159 * MiB + 256 * KiB;
constexpr size_t WS_WT_GU = 160 * MiB;
constexpr size_t WS_WT_D = 192 * MiB;
constexpr size_t WS_WT_O = 208 * MiB, WS_WT_PG = 210 * MiB, WS_WT_PE = 212 * MiB;
constexpr size_t WS_PP = 213 * MiB;
constexpr size_t WS_END = 245 * MiB;
constexpr int CW_BAR = 4096;
constexpr int MAXSLOT = 2 * NTOK + 16 * 256;
constexpr size_t R_HIST = 0, R_TOKE = 16 * KiB, R_TOKW = 144 * KiB, R_TOKSLOT = 272 * KiB, R_SLOT2TOK = 400 * KiB, R_TILE2E = 544 * KiB, R_NRT = 545 * KiB;

struct WS {
    bf16_t *Q; bf16_t* KV[6]; float* GATES; bf16_t* OB; bf16_t* CKV[2]; bf16_t* CAT;
};
static WS make_ws(void* d_ws) {
    WS w; char* p = (char*)d_ws;
    w.Q = (bf16_t*)(p + WS_Q);
    for (int j = 0; j < 6; ++j) w.KV[j] = (bf16_t*)(p + WS_KV + j * KV_STRIDE);
    w.GATES = (float*)(p + WS_GATES); w.OB = (bf16_t*)(p + WS_OB);
    w.CKV[0] = (bf16_t*)(p + WS_CK); w.CKV[1] = (bf16_t*)(p + WS_CV);
    w.CAT = (bf16_t*)(p + WS_CAT);
    return w;
}

constexpr int RING_BYTES = 131072;
constexpr int LDSCTL_OFF = RING_BYTES;
constexpr int LDS_BYTES = 147456;
constexpr int NWAVES = 8;

typedef unsigned v4u __attribute__((ext_vector_type(4)));
typedef unsigned v2u __attribute__((ext_vector_type(2)));
typedef float f32x4 __attribute__((ext_vector_type(4)));
#define LDS_WAIT() asm volatile("s_waitcnt lgkmcnt(0)" ::: "memory")
#define VM_WAIT() asm volatile("s_waitcnt vmcnt(0)" ::: "memory")

__device__ __forceinline__ bool in_group_is_rope(int G) { return (G >= 8 && G < 12) || G == 12 || G == 14 || G == 16; }
__device__ __forceinline__ int in_dest_row(int c) {
    const int G = c >> 7, lo = c & 127; int wc, n, fq, i = lo & 3;
    if (in_group_is_rope(G)) { const int hd = lo >> 6; n = (lo >> 5) & 1; const int wcl = (lo >> 4) & 1; fq = (lo >> 2) & 3; wc = 2 * hd + wcl; }
    else { wc = lo >> 5; fq = (lo >> 3) & 3; n = (lo >> 2) & 1; }
    return (G << 7) + 32 * wc + 16 * n + 4 * fq + i;
}
template <class F>
__device__ __forceinline__ void p0_transpose_item(const float* W, int ldw, int ncols, bf16_t* WT, int ldt, F dest, LAS float* scr, int k0, int n0, int lane) {
#pragma unroll 8
    for (int i = 0; i < 32; ++i) { const int kk = 2 * i + (lane >> 5), col = n0 + (lane & 31); scr[kk * 33 + (lane & 31)] = (col < ncols) ? W[(size_t)(k0 + kk) * ldw + col] : 0.f; }
    LDS_WAIT(); asm volatile("" ::: "memory");
    const int c = lane & 7;
#pragma unroll
    for (int j = 0; j < 4; ++j) { const int n = (lane >> 3) + 8 * j; const LAS float* s = scr + (8 * c) * 33 + n;
        v4u o; o.x = pk2(s[0 * 33], s[1 * 33]); o.y = pk2(s[2 * 33], s[3 * 33]); o.z = pk2(s[4 * 33], s[5 * 33]); o.w = pk2(s[6 * 33], s[7 * 33]);
        *(v4u*)(WT + (size_t)dest(n0 + n) * ldt + k0 + 8 * c) = o; }
    LDS_WAIT(); asm volatile("" ::: "memory");
}
__device__ __forceinline__ void rms_row_to_bf16(const float* xrow, const float* gain, bf16_t* orow, int lane) {
    const f32x4* xr = (const f32x4*)xrow + lane; const f32x4* gr = (const f32x4*)gain + lane;
    f32x4 v[4]; float s = 0.f;
#pragma unroll
    for (int j = 0; j < 4; ++j) { v[j] = xr[64 * j]; s += (v[j].x * v[j].x + v[j].y * v[j].y) + (v[j].z * v[j].z + v[j].w * v[j].w); }
    const float r = rsqrtf(wave_sum(s) * (1.f / 1024.f) + EPS);
    v2u* o8 = (v2u*)orow + lane;
#pragma unroll
    for (int j = 0; j < 4; ++j) { const f32x4 g = gr[64 * j]; v2u o; o.x = pk2(v[j].x * r * g.x, v[j].y * r * g.y); o.y = pk2(v[j].z * r * g.z, v[j].w * r * g.w); o8[64 * j] = o; }
}

struct EpiIn {
    static constexpr bool PERM = false, AFTER_DRAIN = false;
    bf16_t *U, *V, *Q, *KV0; float* GATES; const float *rC, *rS; float* VSQ;
    __device__ __forceinline__ void operator()(const pg8::f32x4 (&acc)[2][2][4][2], const pg8::Unit& u, int wr, int wc, int fr, int fq) const {
#pragma unroll
        for (int bj = 0; bj < 2; ++bj) {
            const int G = 2 * u.pn + bj;
            if (G > 18) continue;
#pragma unroll
            for (int ai = 0; ai < 2; ++ai)
#pragma unroll
                for (int m = 0; m < 4; ++m) {
                    const int r = u.pm * 256 + ai * 128 + wr * 64 + m * 16 + fr;
                    const pg8::f32x4 v0 = acc[ai][bj][m][0], v1 = acc[ai][bj][m][1];
                    if (G < 4) {
                        v4u o; o.x = pk2(gelu_fast(v0[0]), gelu_fast(v0[1])); o.y = pk2(gelu_fast(v0[2]), gelu_fast(v0[3])); o.z = pk2(gelu_fast(v1[0]), gelu_fast(v1[1])); o.w = pk2(gelu_fast(v1[2]), gelu_fast(v1[3]));
                        *(v4u*)(U + (size_t)r * 512 + G * 128 + 32 * wc + 8 * fq) = o;
                    } else if (G < 8) {
                        float gq[8]; float ssq = 0.f;
#pragma unroll
                        for (int i = 0; i < 4; ++i) { gq[i] = gelu_fast(v0[i]); gq[4 + i] = gelu_fast(v1[i]); ssq += gq[i] * gq[i] + gq[4 + i] * gq[4 + i]; }
                        ssq += __shfl_xor(ssq, 16); ssq += __shfl_xor(ssq, 32);
                        if (fq == 0) VSQ[(size_t)r * 16 + (G - 4) * 4 + wc] = ssq;
                        bf16_t* dst = V + ((size_t)(r >> 7) * 512 + (G - 4) * 128 + 32 * wc + 8 * fq) * 128 + (r & 127);
#pragma unroll
                        for (int i = 0; i < 8; ++i) dst[i * 128] = f2bf(gq[i]);
                    } else if (G == 18) {
                        if (wc == 0 && fq < 3) { float* dst = GATES + (size_t)r * 24 + 8 * fq;
                            *(f32x4*)dst = (f32x4){sigmoidf_(v0[0]), sigmoidf_(v0[1]), sigmoidf_(v0[2]), sigmoidf_(v0[3])};
                            *(f32x4*)(dst + 4) = (f32x4){sigmoidf_(v1[0]), sigmoidf_(v1[1]), sigmoidf_(v1[2]), sigmoidf_(v1[3])}; }
                    } else if (G < 12 || ((G - 12) & 1) == 0) {
                        const int t = r & (SEQ - 1), b = r >> 13, dd = 16 * (wc & 1) + 4 * fq;
                        const f32x4 cs = *(const f32x4*)(rC + t * 32 + dd), sn = *(const f32x4*)(rS + t * 32 + dd);
                        const float sc = (G < 12) ? 0.125f : 1.0f;
                        float o1[4], o2[4];
#pragma unroll
                        for (int i = 0; i < 4; ++i) { o1[i] = (v0[i] * cs[i] - v1[i] * sn[i]) * sc; o2[i] = (v0[i] * sn[i] + v1[i] * cs[i]) * sc; }
                        bf16_t* dst = (G < 12) ? Q + (size_t)r * 512 + (2 * (G - 8) + (wc >> 1)) * 64 + dd
                                               : KV0 + (size_t)(G - 12) * (KV_STRIDE / 2) + ((size_t)(b * 2 + (wc >> 1)) * SEQ + t) * 64 + dd;
                        v2u a; a.x = pk2(o1[0], o1[1]); a.y = pk2(o1[2], o1[3]); *(v2u*)dst = a;
                        v2u c; c.x = pk2(o2[0], o2[1]); c.y = pk2(o2[2], o2[3]); *(v2u*)(dst + 32) = c;
                    } else if (G == 13) {
                        const int t = r & (SEQ - 1), b = r >> 13;
                        bf16_t* dst = KV0 + (size_t)(G - 12) * (KV_STRIDE / 2) + ((size_t)(b * 2 + (wc >> 1)) * SEQ + t) * 64 + ((32 * wc + 8 * fq) & 63);
                        v4u o; o.x = pk2(v0[0], v0[1]); o.y = pk2(v0[2], v0[3]); o.z = pk2(v1[0], v1[1]); o.w = pk2(v1[2], v1[3]);
                        *(v4u*)dst = o;
                    } else {
                        const int t = r & (SEQ - 1), b = r >> 13, t16 = t & 15, pt = (t & ~15) + (t16 & 3) + (((t16 >> 2) & 1) << 3) + (((t16 >> 3) & 1) << 2);
                        bf16_t* dst = KV0 + (size_t)(G - 12) * (KV_STRIDE / 2) + ((size_t)(b * 2 + (wc >> 1)) * 64 + ((32 * wc + 8 * fq) & 63)) * SEQ + pt;
#pragma unroll
                        for (int i = 0; i < 4; ++i) { dst[(size_t)i * SEQ] = f2bf(v0[i]); dst[(size_t)(4 + i) * SEQ] = f2bf(v1[i]); }
                    }
                }
        }
    }
};

__device__ __forceinline__ int nat_dest_row(int c) { const int lo = c & 127; return (c & ~127) + 32 * (lo >> 5) + 16 * ((lo >> 2) & 1) + 4 * ((lo >> 3) & 3) + (lo & 3); }
__device__ __forceinline__ int gu_dest_row(int j) { const int jl = j & 63; return 128 * (j >> 6) + 32 * (jl >> 4) + 4 * ((jl >> 2) & 3) + (jl & 3); }

struct EpiBf16N {
    static constexpr bool PERM = false, AFTER_DRAIN = false;
    bf16_t* O; int ldc; int pn_mask;
    __device__ __forceinline__ void operator()(const pg8::f32x4 (&acc)[2][2][4][2], const pg8::Unit& u, int wr, int wc, int fr, int fq) const {
        const int col0 = (u.pn & pn_mask) * 256 + 32 * wc + 8 * fq;
#pragma unroll
        for (int ai = 0; ai < 2; ++ai)
#pragma unroll
            for (int m = 0; m < 4; ++m) { bf16_t* rowp = O + (size_t)(u.pm * 256 + ai * 128 + wr * 64 + m * 16 + fr) * ldc + col0;
#pragma unroll
                for (int bj = 0; bj < 2; ++bj) { const pg8::f32x4 v0 = acc[ai][bj][m][0], v1 = acc[ai][bj][m][1];
                    v4u o; o.x = pk2(v0[0], v0[1]); o.y = pk2(v0[2], v0[3]); o.z = pk2(v1[0], v1[1]); o.w = pk2(v1[2], v1[3]); *(v4u*)(rowp + bj * 128) = o; } }
    }
};
struct EpiWo {
    static constexpr bool PERM = false, AFTER_DRAIN = false;
    const float* X; float* O;
    __device__ __forceinline__ void operator()(const pg8::f32x4 (&acc)[2][2][4][2], const pg8::Unit& u, int wr, int wc, int fr, int fq) const {
        const int col0 = u.pn * 256 + 32 * wc + 8 * fq;
#pragma unroll
        for (int ai = 0; ai < 2; ++ai)
#pragma unroll
            for (int m = 0; m < 4; ++m) { const size_t off = (size_t)(u.pm * 256 + ai * 128 + wr * 64 + m * 16 + fr) * 1024 + col0;
#pragma unroll
                for (int bj = 0; bj < 2; ++bj) { const f32x4 x0 = *(const f32x4*)(X + off + bj * 128), x1 = *(const f32x4*)(X + off + bj * 128 + 4);
                    *(f32x4*)(O + off + bj * 128) = x0 + acc[ai][bj][m][0]; *(f32x4*)(O + off + bj * 128 + 4) = x1 + acc[ai][bj][m][1]; } }
    }
};
struct EpiGU {
    static constexpr bool PERM = false, AFTER_DRAIN = false;
    bf16_t* H;
    __device__ __forceinline__ void operator()(const pg8::f32x4 (&acc)[2][2][4][2], const pg8::Unit& u, int wr, int wc, int fr, int fq) const {
        const int col0 = (u.pn & 3) * 128 + 16 * wc + 4 * fq;
#pragma unroll
        for (int ai = 0; ai < 2; ++ai)
#pragma unroll
            for (int m = 0; m < 4; ++m) { bf16_t* rowp = H + (size_t)(u.pm * 256 + ai * 128 + wr * 64 + m * 16 + fr) * 512 + col0;
#pragma unroll
                for (int bj = 0; bj < 2; ++bj) { const pg8::f32x4 a = acc[ai][bj][m][0], b = acc[ai][bj][m][1]; float h[4];
#pragma unroll
                    for (int i = 0; i < 4; ++i) h[i] = a[i] * __builtin_amdgcn_rcpf(1.0f + __builtin_amdgcn_exp2f(-1.4426950408889634f * a[i])) * b[i];
                    v2u o; o.x = pk2(h[0], h[1]); o.y = pk2(h[2], h[3]); *(v2u*)(rowp + bj * 64) = o; } }
    }
};
struct EpiPle {
    static constexpr bool PERM = false, AFTER_DRAIN = false;
    const bf16_t* PP; float* O;
    __device__ __forceinline__ void operator()(const pg8::f32x4 (&acc)[2][2][4][2], const pg8::Unit& u, int wr, int wc, int fr, int fq) const {
        const int col0 = u.pn * 256 + 32 * wc + 8 * fq;
#pragma unroll
        for (int ai = 0; ai < 2; ++ai)
#pragma unroll
            for (int m = 0; m < 4; ++m) { const size_t off = (size_t)(u.pm * 256 + ai * 128 + wr * 64 + m * 16 + fr) * 1024 + col0;
#pragma unroll
                for (int bj = 0; bj < 2; ++bj) { const v4u pp = *(const v4u*)(PP + off + bj * 128);
                    f32x4 o0 = *(const f32x4*)(O + off + bj * 128), o1 = *(const f32x4*)(O + off + bj * 128 + 4);
                    const pg8::f32x4 g0 = acc[ai][bj][m][0], g1 = acc[ai][bj][m][1];
                    const float p_[8] = {__uint_as_float(pp.x << 16), __uint_as_float(pp.x & 0xffff0000u), __uint_as_float(pp.y << 16), __uint_as_float(pp.y & 0xffff0000u),
                                         __uint_as_float(pp.z << 16), __uint_as_float(pp.z & 0xffff0000u), __uint_as_float(pp.w << 16), __uint_as_float(pp.w & 0xffff0000u)};
#pragma unroll
                    for (int i = 0; i < 4; ++i) { o0[i] += p_[i] * __builtin_amdgcn_rcpf(1.0f + __builtin_amdgcn_exp2f(-1.4426950408889634f * g0[i]));
                                                  o1[i] += p_[4 + i] * __builtin_amdgcn_rcpf(1.0f + __builtin_amdgcn_exp2f(-1.4426950408889634f * g1[i])); }
                    *(f32x4*)(O + off + bj * 128) = o0; *(f32x4*)(O + off + bj * 128 + 4) = o1; } }
    }
};
struct MoeOrder {
    int nun, G, c; const int* tile2e;
    __device__ bool next(int i, pg8::Unit& u) const {
        const long L = (long)i * G + c; if (L >= nun) return false;
        int wgid = (int)L; { const int q = nun / 8, r = nun % 8, xcd = wgid % 8, off = wgid / 8; wgid = (xcd < r ? xcd * (q + 1) : r * (q + 1) + (xcd - r) * q) + off; }
        u.pm = wgid >> 2; u.pn = tile2e[u.pm] * 4 + (wgid & 3); return true;
    }
    __device__ __forceinline__ void a_ready(const pg8::Unit&) const {}
    __device__ __forceinline__ void done(const pg8::Unit&) const {}
};

typedef short bf16x8 __attribute__((ext_vector_type(8)));
typedef float f32x16 __attribute__((ext_vector_type(16)));
__device__ __forceinline__ float bflo(unsigned u) { return __uint_as_float(u << 16); }
__device__ __forceinline__ float bfhi(unsigned u) { return __uint_as_float(u & 0xffff0000u); }

__device__ __forceinline__ void gmlp_unit(int bc, const bf16_t* __restrict__ U, const bf16_t* __restrict__ VT, const float* __restrict__ VSQ, const bf16_t* __restrict__ WTRI,
                                          const float* __restrict__ g_v, const float* __restrict__ b_s, const float* __restrict__ g_a, bf16_t* CAT, LAS unsigned char* lds, int tid, int lane, int wave) {
    LAS float* rstd = (LAS float*)lds;
    LAS float* osq = rstd + 128;
    const int tok0 = bc * 128, g = wave, fr = lane & 15, fq = lane >> 4;
    __syncthreads();
    if (tid < 128) { const f32x4* q4 = (const f32x4*)(VSQ + (size_t)(tok0 + tid) * 16); const f32x4 a = q4[0], b = q4[1], c = q4[2], d = q4[3];
        const float sm = ((a.x + a.y) + (a.z + a.w)) + ((b.x + b.y) + (b.z + b.w)) + ((c.x + c.y) + (c.z + c.w)) + ((d.x + d.y) + (d.z + d.w));
        rstd[tid] = rsqrtf(sm * (1.f / 512.f) + EPS); }
    __syncthreads();
    const bf16_t* VTc = VT + (size_t)bc * 512 * 128 + (size_t)(64 * g) * 128;
    const bf16_t* Wg = WTRI + (size_t)g * 128 * 128;
#pragma unroll 1
    for (int half = 0; half < 2; ++half) {
    pg8::f32x4 oa[4][4]; float sq[4];
#pragma unroll
    for (int jj = 0; jj < 4; ++jj) {
        const int j = 4 * half + jj;
        pg8::f32x4 acc[4];
#pragma unroll
        for (int dt = 0; dt < 4; ++dt) acc[dt] = (pg8::f32x4){0.f, 0.f, 0.f, 0.f};
        const int nks = (16 * j + 16 + 31) / 32;
#pragma unroll 1
        for (int ks = 0; ks < nks; ++ks) {
            const int s0 = 32 * ks + 8 * fq;
            const v4u wraw = *(const v4u*)(Wg + (16 * j + fr) * 128 + s0);
            const f32x4 r0 = *(const LAS f32x4*)(rstd + s0), r1 = *(const LAS f32x4*)(rstd + s0 + 4);
            v4u wsc; wsc.x = pk2(bflo(wraw.x) * r0.x, bfhi(wraw.x) * r0.y); wsc.y = pk2(bflo(wraw.y) * r0.z, bfhi(wraw.y) * r0.w);
            wsc.z = pk2(bflo(wraw.z) * r1.x, bfhi(wraw.z) * r1.y); wsc.w = pk2(bflo(wraw.w) * r1.z, bfhi(wraw.w) * r1.w);
            const bf16x8 wb = __builtin_bit_cast(bf16x8, wsc);
#pragma unroll
            for (int dt = 0; dt < 4; ++dt) { const bf16x8 a = *(const bf16x8*)(VTc + (16 * dt + fr) * 128 + s0); acc[dt] = __builtin_amdgcn_mfma_f32_16x16x32_bf16(a, wb, acc[dt], 0, 0, 0); }
        }
        const int t = 16 * j + fr; const size_t tok = (size_t)(tok0 + t); const float bias = b_s[g * 128 + t]; float q = 0.f;
#pragma unroll
        for (int dt = 0; dt < 4; ++dt) { const int col = 64 * g + 16 * dt + 4 * fq; const v2u u2 = *(const v2u*)(U + tok * 512 + col); const f32x4 gv = *(const f32x4*)(g_v + col);
            pg8::f32x4 o; o[0] = bflo(u2.x) * (gv.x * acc[dt][0] + bias); o[1] = bfhi(u2.x) * (gv.y * acc[dt][1] + bias); o[2] = bflo(u2.y) * (gv.z * acc[dt][2] + bias); o[3] = bfhi(u2.y) * (gv.w * acc[dt][3] + bias);
            oa[jj][dt] = o; q += (o[0] * o[0] + o[1] * o[1]) + (o[2] * o[2] + o[3] * o[3]); }
        q += __shfl_xor(q, 16); q += __shfl_xor(q, 32); sq[jj] = q;
    }
#pragma unroll
    for (int jj = 0; jj < 4; ++jj) if (fq == 0) osq[g * 128 + 16 * (4 * half + jj) + fr] = sq[jj];
    __syncthreads();
#pragma unroll
    for (int jj = 0; jj < 4; ++jj) { const int t = 16 * (4 * half + jj) + fr; float sm = 0.f;
#pragma unroll
        for (int gg = 0; gg < 8; ++gg) sm += osq[gg * 128 + t];
        const float ra = rsqrtf(sm * (1.f / 512.f) + EPS); const size_t tok = (size_t)(tok0 + t);
#pragma unroll
        for (int dt = 0; dt < 4; ++dt) { const int col = 64 * g + 16 * dt + 4 * fq; const f32x4 ga = *(const f32x4*)(g_a + col); const pg8::f32x4 o = oa[jj][dt];
            v2u w; w.x = pk2(o[0] * ra * ga.x, o[1] * ra * ga.y); w.y = pk2(o[2] * ra * ga.z, o[3] * ra * ga.w); *(v2u*)(CAT + tok * 1024 + col) = w; } }
    }
}

constexpr int HSTR = 528;
__device__ __forceinline__ void compress_unit(int cu, const bf16_t* __restrict__ KVX, const bf16_t* __restrict__ W1T, const bf16_t* __restrict__ W2T, const float* __restrict__ CBIAS,
                                              bf16_t* CK, bf16_t* CVp, LAS unsigned char* lds, int lane, int wave) {
    const int kv = cu >> 6, bg = (cu >> 4) & 3, c0 = (cu & 15) * 32;
    const bf16_t* X = KVX + (size_t)kv * (KV_STRIDE / 2) + (size_t)bg * SEQ * 64;
    const bf16_t* w1t = W1T + (size_t)kv * 256 * 2048; const bf16_t* w2t = W2T + (size_t)kv * 64 * 256; const float* bias = CBIAS + kv * 256;
    const int r32 = lane & 31, h = lane >> 5, n0 = 32 * wave;
    const bf16_t* ap = w1t + (size_t)(n0 + r32) * 2048 + 8 * h; const bf16_t* bp = X + (size_t)(c0 + r32) * 1024 + 8 * h;
    f32x16 acc;
#pragma unroll
    for (int i = 0; i < 16; ++i) acc[i] = 0.f;
#pragma unroll 8
    for (int s = 0; s < 128; ++s) { const bf16x8 a = *(const bf16x8*)(ap + 16 * s); const bf16x8 b = *(const bf16x8*)(bp + 16 * s); acc = __builtin_amdgcn_mfma_f32_32x32x16_bf16(a, b, acc, 0, 0, 0); }
    __syncthreads();
#pragma unroll
    for (int rg = 0; rg < 4; ++rg) { const int n = n0 + 8 * rg + 4 * h; const f32x4 bv = *(const f32x4*)(bias + n);
        v2u w; w.x = pk2(gelu_fast(acc[4 * rg] + bv.x), gelu_fast(acc[4 * rg + 1] + bv.y)); w.y = pk2(gelu_fast(acc[4 * rg + 2] + bv.z), gelu_fast(acc[4 * rg + 3] + bv.w));
        *(LAS v2u*)(lds + r32 * HSTR + n * 2) = w; }
    __syncthreads();
    if (wave < 2) {
        f32x16 o;
#pragma unroll
        for (int i = 0; i < 16; ++i) o[i] = 0.f;
        const bf16_t* wp = w2t + (size_t)(32 * wave + r32) * 256 + 8 * h; LAS unsigned char* hp = lds + r32 * HSTR + 16 * h;
        if (kv == 0) {
#pragma unroll
            for (int s = 0; s < 16; ++s) { const bf16x8 a = *(const bf16x8*)(wp + 16 * s); const bf16x8 b = *(const LAS bf16x8*)(hp + 32 * s); o = __builtin_amdgcn_mfma_f32_32x32x16_bf16(a, b, o, 0, 0, 0); }
            bf16_t* dst = CK + ((size_t)bg * NCP + c0 + r32) * 64 + 32 * wave + 4 * h;
#pragma unroll
            for (int rg = 0; rg < 4; ++rg) { v2u w; w.x = pk2(o[4 * rg], o[4 * rg + 1]); w.y = pk2(o[4 * rg + 2], o[4 * rg + 3]); *(v2u*)(dst + 8 * rg) = w; }
        } else {
#pragma unroll
            for (int s = 0; s < 16; ++s) { const bf16x8 a = *(const LAS bf16x8*)(hp + 32 * s); const bf16x8 b = *(const bf16x8*)(wp + 16 * s); o = __builtin_amdgcn_mfma_f32_32x32x16_bf16(a, b, o, 0, 0, 0); }
            bf16_t* dst = CVp + ((size_t)bg * 64 + 32 * wave + r32) * NCP + c0 + 8 * h;
#pragma unroll
            for (int rg = 0; rg < 4; ++rg) { v2u w; w.x = pk2(o[4 * rg], o[4 * rg + 1]); w.y = pk2(o[4 * rg + 2], o[4 * rg + 3]); *(v2u*)(dst + 16 * (rg >> 1) + 4 * (rg & 1)) = w; }
        }
    }
}

constexpr float L2E = 1.4426950408889634f, MASKV = -3.0e38f, MINIT = -1.0e30f;
constexpr int AT_ROW = 144, AT_TILE = 64 * AT_ROW;
constexpr int AT_IMP = 8 * AT_TILE, AT_SELM = AT_IMP + 32768, AT_OBSQ = AT_SELM + 1024;
__device__ __forceinline__ int at_tile_off(int bufi, int g, int kv) { return ((bufi * 2 + g) * 2 + kv) * AT_TILE; }
__device__ __forceinline__ bf16x8 at_frag(LAS unsigned char* lanebase, int rowoff, int ch) { return *(const LAS bf16x8*)(lanebase + rowoff * AT_ROW + ch * 32); }
__device__ __forceinline__ float xh_sum(float x) { const auto rr = __builtin_amdgcn_permlane32_swap(__float_as_uint(x), __float_as_uint(x), false, false); return __uint_as_float(rr[0]) + __uint_as_float(rr[1]); }
__device__ __forceinline__ float xh_max(float x) { const auto rr = __builtin_amdgcn_permlane32_swap(__float_as_uint(x), __float_as_uint(x), false, false); return fmaxf(__uint_as_float(rr[0]), __uint_as_float(rr[1])); }
__device__ __forceinline__ float quad_sum(float x) { x += __uint_as_float(__builtin_amdgcn_update_dpp(0, __float_as_uint(x), 0xB1, 0xf, 0xf, false)); x += __uint_as_float(__builtin_amdgcn_update_dpp(0, __float_as_uint(x), 0x4E, 0xf, 0xf, false)); return x; }
__device__ __forceinline__ int at_key(int mt, int r, int h) { return 32 * mt + (r & 3) + 8 * (r >> 2) + 4 * h; }

__device__ __forceinline__ void at_qk(LAS unsigned char* kl, const bf16x8 (&qf)[4], f32x16& S0, f32x16& S1) {
#pragma unroll
    for (int i = 0; i < 16; ++i) { S0[i] = 0.f; S1[i] = 0.f; }
#pragma unroll
    for (int s = 0; s < 4; ++s) { const bf16x8 a0 = at_frag(kl, 0, s), a1 = at_frag(kl, 32, s);
        S0 = __builtin_amdgcn_mfma_f32_32x32x16_bf16(a0, qf[s], S0, 0, 0, 0); S1 = __builtin_amdgcn_mfma_f32_32x32x16_bf16(a1, qf[s], S1, 0, 0, 0); }
}
__device__ __forceinline__ void at_pv(LAS unsigned char* vl, const f32x16& S0, const f32x16& S1, f32x16 (&O)[2]) {
    bf16x8 pf[4];
#pragma unroll
    for (int s = 0; s < 2; ++s) { v4u a, b;
        a.x = pk2(S0[8 * s], S0[8 * s + 1]); a.y = pk2(S0[8 * s + 2], S0[8 * s + 3]); a.z = pk2(S0[8 * s + 4], S0[8 * s + 5]); a.w = pk2(S0[8 * s + 6], S0[8 * s + 7]);
        b.x = pk2(S1[8 * s], S1[8 * s + 1]); b.y = pk2(S1[8 * s + 2], S1[8 * s + 3]); b.z = pk2(S1[8 * s + 4], S1[8 * s + 5]); b.w = pk2(S1[8 * s + 6], S1[8 * s + 7]);
        pf[s] = __builtin_bit_cast(bf16x8, a); pf[2 + s] = __builtin_bit_cast(bf16x8, b); }
#pragma unroll
    for (int dt = 0; dt < 2; ++dt)
#pragma unroll
        for (int ks = 0; ks < 4; ++ks) { const bf16x8 a = at_frag(vl, 32 * dt, ks); O[dt] = __builtin_amdgcn_mfma_f32_32x32x16_bf16(a, pf[ks], O[dt], 0, 0, 0); }
}
__device__ __forceinline__ void at_softmax(f32x16& S0, f32x16& S1, float& m, float& l, f32x16 (&O)[2]) {
    float mx = MASKV;
#pragma unroll
    for (int r = 0; r < 16; ++r) mx = fmaxf(mx, fmaxf(S0[r], S1[r]));
    mx = xh_max(mx);
    const float mn = fmaxf(m, mx);
    if (__any(mn > m)) { const float al = __builtin_amdgcn_exp2f((m - mn) * L2E); l *= al;
#pragma unroll
        for (int r = 0; r < 16; ++r) { O[0][r] *= al; O[1][r] *= al; } }
    m = mn; const float mL = mn * L2E; float sm = 0.f;
#pragma unroll
    for (int r = 0; r < 16; ++r) { S0[r] = __builtin_amdgcn_exp2f(__builtin_fmaf(S0[r], L2E, -mL)); S1[r] = __builtin_amdgcn_exp2f(__builtin_fmaf(S1[r], L2E, -mL)); sm += S0[r] + S1[r]; }
    l += sm;
}

__device__ __forceinline__ void attn_unit(int b, int jq, const bf16_t* __restrict__ Q, const bf16_t* __restrict__ CK, const bf16_t* __restrict__ CVp, const bf16_t* __restrict__ KS, const bf16_t* __restrict__ VSp,
                                          const bf16_t* __restrict__ KW, const bf16_t* __restrict__ VWp, const float* __restrict__ GATES, const float* __restrict__ g_b, bf16_t* CAT,
                                          LAS unsigned char* lds, int tid, int lane, int wave) {
    asm volatile("" : "+v"(lane), "+v"(tid));
    const int g = wave >> 2, wq = wave & 3, bg = 2 * b + g, r32 = lane & 31, h = lane >> 5, qi = r32 >> 2, hd = r32 & 3, htid = tid & 255;
    const int t = 32 * jq + 8 * wq + qi, cur = jq >> 1; const size_t tok = (size_t)b * SEQ + t;
    LAS float* IMPALL = (LAS float*)(lds + AT_IMP); LAS float* IMP = IMPALL + (g * 32 + 8 * wq + qi) * 128;
    LAS unsigned* SELM = (LAS unsigned*)(lds + AT_SELM); LAS float* OBSQ = (LAS float*)(lds + AT_OBSQ);
    const int srow = htid >> 3, sch = htid & 7, soff = srow * AT_ROW + sch * 16;
    const int lpart = r32 * AT_ROW + h * 16;
    v4u sr[4]; int bi = 0;
#define AT_LOAD_K(ptr, stride) do { sr[0] = *(const v4u*)((ptr) + (size_t)srow * (stride) + 8 * sch); sr[1] = *(const v4u*)((ptr) + (size_t)(srow + 32) * (stride) + 8 * sch); } while (0)
#define AT_LOAD_V(ptr, stride) do { sr[2] = *(const v4u*)((ptr) + (size_t)srow * (stride) + 8 * sch); sr[3] = *(const v4u*)((ptr) + (size_t)(srow + 32) * (stride) + 8 * sch); } while (0)
#define AT_STORE_K(bufi) do { LAS unsigned char* d_ = lds + at_tile_off(bufi, g, 0) + soff; *(LAS v4u*)d_ = sr[0]; *(LAS v4u*)(d_ + 32 * AT_ROW) = sr[1]; } while (0)
#define AT_STORE_V(bufi) do { LAS unsigned char* d_ = lds + at_tile_off(bufi, g, 1) + soff; *(LAS v4u*)d_ = sr[2]; *(LAS v4u*)(d_ + 32 * AT_ROW) = sr[3]; } while (0)
    __syncthreads();
    bf16x8 qf[4];
#pragma unroll
    for (int s = 0; s < 4; ++s) qf[s] = *(const bf16x8*)(Q + tok * 512 + (4 * g + hd) * 64 + 16 * s + 8 * h);
    { LAS float* z = IMPALL + (g * 32 + 8 * wq) * 128;
#pragma unroll
      for (int i = 0; i < 16; ++i) z[lane + 64 * i] = 0.f; }
    if (tid < 256) SELM[tid] = 0u;
    f32x16 S0, S1, O[2], oacc[2];
    const float* gt = GATES + tok * 24 + (4 * g + hd) * 3; const float g0 = gt[0], g1 = gt[1], g2 = gt[2];

    const int nct = (2 * jq + 1 + 63) >> 6; const int cmax = (t >= 31) ? ((t - 31) >> 4) : -1;
    const bf16_t* Kc = CK + (size_t)bg * NCP * 64; const bf16_t* Vc = CVp + (size_t)bg * 64 * NCP;
    float m = MINIT, l = 0.f;
    AT_LOAD_K(Kc, 64); AT_STORE_K(bi); __syncthreads();
#pragma unroll 1
    for (int ct = 0; ct < nct; ++ct) {
        if (ct + 1 < nct) AT_LOAD_K(Kc + (size_t)(ct + 1) * 64 * 64, 64);
        at_qk(lds + at_tile_off(bi, g, 0) + lpart, qf, S0, S1);
#pragma unroll
        for (int r = 0; r < 16; ++r) { const int thr = cmax - 64 * ct - 4 * h; if (at_key(0, r, 0) > thr) S0[r] = MASKV; if (at_key(1, r, 0) > thr) S1[r] = MASKV; }
        float mx = MASKV;
#pragma unroll
        for (int r = 0; r < 16; ++r) mx = fmaxf(mx, fmaxf(S0[r], S1[r]));
        mx = xh_max(mx);
        const float mn = fmaxf(m, mx); l *= __builtin_amdgcn_exp2f((m - mn) * L2E); m = mn; const float mL0 = mn * L2E; float sm = 0.f;
#pragma unroll
        for (int r = 0; r < 16; ++r) sm += __builtin_amdgcn_exp2f(__builtin_fmaf(S0[r], L2E, -mL0)) + __builtin_amdgcn_exp2f(__builtin_fmaf(S1[r], L2E, -mL0));
        l += sm;
        if (ct + 1 < nct) AT_STORE_K(bi ^ 1);
        __syncthreads(); bi ^= 1;
    }
    l = xh_sum(l);
    const float inv_l = 1.0f / fmaxf(l, 1e-30f), mLc = m * L2E;
#pragma unroll
    for (int r = 0; r < 16; ++r) { O[0][r] = 0.f; O[1][r] = 0.f; }
    AT_LOAD_K(Kc, 64); AT_LOAD_V(Vc, NCP); AT_STORE_K(bi); AT_STORE_V(bi); __syncthreads();
#pragma unroll 1
    for (int ct = 0; ct < nct; ++ct) {
        if (ct + 1 < nct) { AT_LOAD_K(Kc + (size_t)(ct + 1) * 64 * 64, 64); AT_LOAD_V(Vc + (size_t)(ct + 1) * 64, NCP); }
        at_qk(lds + at_tile_off(bi, g, 0) + lpart, qf, S0, S1);
#pragma unroll
        for (int r = 0; r < 16; ++r) {
            const int thr = cmax - 64 * ct - 4 * h;
            S0[r] = (at_key(0, r, 0) > thr) ? 0.f : __builtin_amdgcn_exp2f(__builtin_fmaf(S0[r], L2E, -mLc)) * inv_l;
            S1[r] = (at_key(1, r, 0) > thr) ? 0.f : __builtin_amdgcn_exp2f(__builtin_fmaf(S1[r], L2E, -mLc)) * inv_l; }
#pragma unroll
        for (int mt = 0; mt < 2; ++mt)
#pragma unroll
            for (int k = 0; k < 4; ++k) {
                const float p0 = mt ? S1[4 * k] : S0[4 * k], p1 = mt ? S1[4 * k + 1] : S0[4 * k + 1], p2 = mt ? S1[4 * k + 2] : S0[4 * k + 2], p3 = mt ? S1[4 * k + 3] : S0[4 * k + 3];
                float bs = (p0 + p1) + (p2 + p3), ts = p3;
                bs = quad_sum(bs); ts = quad_sum(ts);
                const int blk = 16 * ct + 8 * mt + 2 * k + h;
                if (hd == 0) { IMP[blk] += bs; if (blk + 1 < 128) IMP[blk + 1] += ts; }
            }
        at_pv(lds + at_tile_off(bi, g, 1) + lpart, S0, S1, O);
        if (ct + 1 < nct) { AT_STORE_K(bi ^ 1); AT_STORE_V(bi ^ 1); }
        __syncthreads(); bi ^= 1;
    }
#pragma unroll
    for (int r = 0; r < 16; ++r) { oacc[0][r] = g0 * O[0][r]; oacc[1][r] = g0 * O[1][r]; }
    {
        const int nforced = cur >= 2 ? 3 : cur + 1, need = 16 - nforced, ncand = cur - 2;
#pragma unroll 1
        for (int i = 0; i < 8; ++i) {
            const int row = wave * 8 + i; LAS float* ir = IMPALL + row * 128;
            const int s0 = lane, s1 = lane + 64;
            const bool c0 = (s0 >= 1 && s0 <= cur - 2), c1 = (s1 <= cur - 2);
            const unsigned x0 = c0 ? __float_as_uint(ir[s0]) + 1u : 0u, x1 = c1 ? __float_as_uint(ir[s1]) + 1u : 0u;
            bool sel0 = c0, sel1 = c1;
            if (ncand > need) {
                unsigned lo = 1u, hi = 0x7f800002u; bool exact = false;
                while (hi - lo > 1u) { const unsigned mid = lo + ((hi - lo) >> 1);
                    const int c = __popcll(__ballot(x0 >= mid)) + __popcll(__ballot(x1 >= mid));
                    if (c == need) { lo = mid; exact = true; break; }
                    if (c > need) lo = mid; else hi = mid; }
                if (exact) { sel0 = x0 >= lo; sel1 = x1 >= lo; }
                else { const unsigned long long gt0 = __ballot(x0 > lo), gt1 = __ballot(x1 > lo), eq0 = __ballot(x0 == lo), eq1 = __ballot(x1 == lo);
                    const int need2 = need - (__popcll(gt0) + __popcll(gt1)); const unsigned long long lm = (1ull << lane) - 1ull;
                    sel0 = (x0 > lo) || (x0 == lo && __popcll(eq0 & lm) < need2);
                    sel1 = (x1 > lo) || (x1 == lo && __popcll(eq0) + __popcll(eq1 & lm) < need2); }
            }
            const bool f0 = (s0 == 0) || (s0 == cur) || (s0 == cur - 1), f1 = (s1 == cur) || (s1 == cur - 1);
            const unsigned long long b0 = __ballot(sel0 || f0), b1 = __ballot(sel1 || f1);
            if (lane == 0) { SELM[row * 4] = (unsigned)b0; SELM[row * 4 + 1] = (unsigned)(b0 >> 32); SELM[row * 4 + 2] = (unsigned)b1; SELM[row * 4 + 3] = (unsigned)(b1 >> 32); }
        }
    }
    __syncthreads();
    {
        const LAS unsigned* sw = SELM + (g * 32 + 8 * wq + qi) * 4; const unsigned sw0 = sw[0], sw1 = sw[1], sw2 = sw[2], sw3 = sw[3];
        const bf16_t* Ks = KS + (size_t)bg * SEQ * 64; const bf16_t* Vs = VSp + (size_t)bg * 64 * SEQ;
        m = MINIT; l = 0.f;
#pragma unroll
        for (int r = 0; r < 16; ++r) { O[0][r] = 0.f; O[1][r] = 0.f; }
        AT_LOAD_K(Ks, 64); AT_LOAD_V(Vs, SEQ); AT_STORE_K(bi); AT_STORE_V(bi); __syncthreads();
#pragma unroll 1
        for (int blk = 0; blk <= cur; ++blk) {
            if (blk < cur) { AT_LOAD_K(Ks + (size_t)(blk + 1) * 64 * 64, 64); AT_LOAD_V(Vs + (size_t)(blk + 1) * 64, SEQ); }
            const unsigned w = blk < 32 ? sw0 : blk < 64 ? sw1 : blk < 96 ? sw2 : sw3; const bool on = (w >> (blk & 31)) & 1u;
            if (__any(on)) {
                at_qk(lds + at_tile_off(bi, g, 0) + lpart, qf, S0, S1);
                if (blk == cur) {
#pragma unroll
                    for (int r = 0; r < 16; ++r) { const int thr = on ? t - 64 * blk - 4 * h : -1; if (at_key(0, r, 0) > thr) S0[r] = MASKV; if (at_key(1, r, 0) > thr) S1[r] = MASKV; }
                } else if (!__all(on)) {
#pragma unroll
                    for (int r = 0; r < 16; ++r) { if (!on) { S0[r] = MASKV; S1[r] = MASKV; } }
                }
                at_softmax(S0, S1, m, l, O);
                at_pv(lds + at_tile_off(bi, g, 1) + lpart, S0, S1, O);
            }
            if (blk < cur) { AT_STORE_K(bi ^ 1); AT_STORE_V(bi ^ 1); }
            __syncthreads(); bi ^= 1;
        }
        l = xh_sum(l); const float f = g1 / l;
#pragma unroll
        for (int r = 0; r < 16; ++r) { oacc[0][r] += f * O[0][r]; oacc[1][r] += f * O[1][r]; }
    }
    {
        const int wb0 = cur > 8 ? cur - 8 : 0;
        const bf16_t* Kw = KW + (size_t)bg * SEQ * 64; const bf16_t* Vw = VWp + (size_t)bg * 64 * SEQ;
        m = MINIT; l = 0.f;
#pragma unroll
        for (int r = 0; r < 16; ++r) { O[0][r] = 0.f; O[1][r] = 0.f; }
        AT_LOAD_K(Kw + (size_t)wb0 * 64 * 64, 64); AT_LOAD_V(Vw + (size_t)wb0 * 64, SEQ); AT_STORE_K(bi); AT_STORE_V(bi); __syncthreads();
#pragma unroll 1
        for (int blk = wb0; blk <= cur; ++blk) {
            if (blk < cur) { AT_LOAD_K(Kw + (size_t)(blk + 1) * 64 * 64, 64); AT_LOAD_V(Vw + (size_t)(blk + 1) * 64, SEQ); }
            at_qk(lds + at_tile_off(bi, g, 0) + lpart, qf, S0, S1);
            if (blk == cur || blk + 8 == cur) {
#pragma unroll
                for (int r = 0; r < 16; ++r) { const int hi_ = t - 64 * blk - 4 * h, lo_ = hi_ - WIN;
                    if (at_key(0, r, 0) > hi_ || at_key(0, r, 0) <= lo_) S0[r] = MASKV; if (at_key(1, r, 0) > hi_ || at_key(1, r, 0) <= lo_) S1[r] = MASKV; }
            }
            at_softmax(S0, S1, m, l, O);
            at_pv(lds + at_tile_off(bi, g, 1) + lpart, S0, S1, O);
            if (blk < cur) { AT_STORE_K(bi ^ 1); AT_STORE_V(bi ^ 1); }
            __syncthreads(); bi ^= 1;
        }
        l = xh_sum(l); const float f = g2 / l;
#pragma unroll
        for (int r = 0; r < 16; ++r) { oacc[0][r] += f * O[0][r]; oacc[1][r] += f * O[1][r]; }
    }
    {
        float q = 0.f;
#pragma unroll
        for (int r = 0; r < 16; ++r) q += oacc[0][r] * oacc[0][r] + oacc[1][r] * oacc[1][r];
        q = xh_sum(q); q = quad_sum(q);
        if (hd == 0 && h == 0) OBSQ[g * 32 + 8 * wq + qi] = q;
        __syncthreads();
        const float rb = rsqrtf((OBSQ[8 * wq + qi] + OBSQ[32 + 8 * wq + qi]) * (1.f / 512.f) + EPS);
#pragma unroll
        for (int dt = 0; dt < 2; ++dt)
#pragma unroll
            for (int rg = 0; rg < 4; ++rg) { const int col = (4 * g + hd) * 64 + 32 * dt + 8 * rg + 4 * h; const f32x4 gb = *(const f32x4*)(g_b + col);
                v2u w; w.x = pk2(oacc[dt][4 * rg] * rb * gb.x, oacc[dt][4 * rg + 1] * rb * gb.y); w.y = pk2(oacc[dt][4 * rg + 2] * rb * gb.z, oacc[dt][4 * rg + 3] * rb * gb.w);
                *(v2u*)(CAT + tok * 1024 + 512 + col) = w; }
    }
#undef AT_LOAD_K
#undef AT_LOAD_V
#undef AT_STORE_K
#undef AT_STORE_V
}

struct Args { const float* in[26]; float* out; unsigned char* ws; int ph_lo, ph_hi, li, pad; };

__global__ void __launch_bounds__(NWAVES * 64, 2) mk_fwd(Args args) {
    extern __shared__ __attribute__((aligned(16))) unsigned char lds_raw[];
    LAS unsigned char* lds = (LAS unsigned char*)lds_raw;
    const int tid = threadIdx.x, lane = tid & 63, wave = __builtin_amdgcn_readfirstlane(tid >> 6);
    const int G = gridDim.x; const int bx = blockIdx.x; const int vcu = (G % 8 == 0) ? (bx % 8) * (G / 8) + bx / 8 : bx;
    unsigned char* ws = args.ws;
    unsigned* ctl = (unsigned*)(ws + WS_CTL);
    for (int u = tid; u < (LDS_BYTES - LDSCTL_OFF) / 4; u += NWAVES * 64) ((LAS unsigned*)(lds + LDSCTL_OFF))[u] = 0u;
    __syncthreads();
    XcdBarrier bar = xcd_barrier_post(ctl + CW_BAR + args.li * XCD_BAR_WORDS, (volatile LAS unsigned*)(lds + LDSCTL_OFF + 320 + 32));
    const int lo = args.ph_lo, hi = args.ph_hi;
#define IN(k) (lo <= (k) && (k) < hi)
#define BOTH(k) (IN(k) && IN((k) + 1))
    const int gw = vcu * NWAVES + wave, NGW = G * NWAVES;

    float* ropeC = (float*)(ws + WS_ROPEC); float* ropeS = (float*)(ws + WS_ROPES);
    bf16_t* WT_IN = (bf16_t*)(ws + WS_WT_IN); bf16_t* HN = (bf16_t*)(ws + WS_HN);
    bf16_t* WT_O = (bf16_t*)(ws + WS_WT_O); bf16_t* WT_PG = (bf16_t*)(ws + WS_WT_PG); bf16_t* WT_PE = (bf16_t*)(ws + WS_WT_PE);
    bf16_t* WT_GU = (bf16_t*)(ws + WS_WT_GU); bf16_t* WT_D = (bf16_t*)(ws + WS_WT_D);
    bf16_t* PBF = (bf16_t*)(ws + WS_PBF); bf16_t* PP = (bf16_t*)(ws + WS_PP); bf16_t* HID = (bf16_t*)(ws + WS_HID); bf16_t* YS = (bf16_t*)(ws + WS_YS);
    bf16_t* W1T = (bf16_t*)(ws + WS_W1T); bf16_t* W2T = (bf16_t*)(ws + WS_W2T); float* CBIAS = (float*)(ws + WS_CBIAS); bf16_t* WTRI = (bf16_t*)(ws + WS_WTRI);
    unsigned char* rt_ = ws + WS_ROUTE;
    int* r_hist = (int*)(rt_ + R_HIST); int* r_toke = (int*)(rt_ + R_TOKE); float* r_tokw = (float*)(rt_ + R_TOKW); int* r_tokslot = (int*)(rt_ + R_TOKSLOT);
    int* r_slot2tok = (int*)(rt_ + R_SLOT2TOK); int* r_tile2e = (int*)(rt_ + R_TILE2E); int* r_nrt = (int*)(rt_ + R_NRT);
    float* out = args.out;

    if (IN(0)) {
        LAS float* scr = (LAS float*)(lds + wave * 16384);
        constexpr int I_IN = 16 * (N_IN_PAD / 32);
        constexpr int I_O = 16 * 32, I_PG = 16 * 32, I_PE = 4 * 32;
        constexpr int I_G = 16 * 16 * 16, I_U = I_G, I_D = 16 * 8 * 32;
        constexpr int NITEMS = I_IN + I_O + I_PG + I_PE + I_G + I_U + I_D;
        for (int it = gw; it < NITEMS; it += NGW) {
            int r = it;
            if (r < I_IN) { const int kb = r / (N_IN_PAD / 32), nb = r % (N_IN_PAD / 32);
                p0_transpose_item(args.in[3], D_IN, D_IN, WT_IN, 1024, [](int c) { return in_dest_row(c); }, scr, 64 * kb, 32 * nb, lane); continue; } r -= I_IN;
            if (r < I_O) { p0_transpose_item(args.in[15], 1024, 1024, WT_O, 1024, [](int c) { return nat_dest_row(c); }, scr, 64 * (r / 32), 32 * (r % 32), lane); continue; } r -= I_O;
            if (r < I_PG) { p0_transpose_item(args.in[24], 1024, 1024, WT_PG, 1024, [](int c) { return nat_dest_row(c); }, scr, 64 * (r / 32), 32 * (r % 32), lane); continue; } r -= I_PG;
            if (r < I_PE) { p0_transpose_item(args.in[23], 1024, 1024, WT_PE, 256, [](int c) { return nat_dest_row(c); }, scr, 64 * (r / 32), 32 * (r % 32), lane); continue; } r -= I_PE;
            if (r < I_G) { const int e = r >> 8, kb = (r >> 4) & 15, nb = r & 15;
                p0_transpose_item(args.in[19] + (size_t)e * 1024 * 512, 512, 512, WT_GU + (size_t)e * 1024 * 1024, 1024, [](int c) { return gu_dest_row(c); }, scr, 64 * kb, 32 * nb, lane); continue; } r -= I_G;
            if (r < I_U) { const int e = r >> 8, kb = (r >> 4) & 15, nb = r & 15;
                p0_transpose_item(args.in[20] + (size_t)e * 1024 * 512, 512, 512, WT_GU + (size_t)e * 1024 * 1024, 1024, [](int c) { return gu_dest_row(c) + 16; }, scr, 64 * kb, 32 * nb, lane); continue; } r -= I_U;
            { const int e = r >> 8, kb = (r >> 5) & 7, nb = r & 31;
                p0_transpose_item(args.in[21] + (size_t)e * 512 * 1024, 1024, 1024, WT_D + (size_t)e * 1024 * 512, 512, [](int c) { return nat_dest_row(c); }, scr, 64 * kb, 32 * nb, lane); }
        }
        for (int it = gw; it < 2 * 256 + 2 * 8 + 128; it += NGW) {
            int r = it;
            if (r < 512) { const int kv = r >> 8, kb = (r >> 3) & 31, nb = r & 7;
                p0_transpose_item(args.in[kv ? 11 : 8], 256, 256, W1T + (size_t)kv * 256 * 2048, 2048, [](int c) { return c; }, scr, 64 * kb, 32 * nb, lane); continue; } r -= 512;
            if (r < 16) { const int kv = r >> 3, kb = (r >> 1) & 3, nb = r & 1;
                p0_transpose_item(args.in[kv ? 12 : 9], 64, 64, W2T + (size_t)kv * 64 * 256, 256, [](int c) { return c; }, scr, 64 * kb, 32 * nb, lane); continue; } r -= 16;
            { const int kv = r >> 6, nq = r & 63; const float* pe = args.in[kv ? 10 : 7]; const float* w1 = args.in[kv ? 11 : 8];
              f32x4 a = (f32x4){0.f, 0.f, 0.f, 0.f};
              for (int k = lane; k < 2048; k += 64) { const float pv = pe[k]; const f32x4 w4 = *(const f32x4*)(w1 + (size_t)k * 256 + 4 * nq); a.x += pv * w4.x; a.y += pv * w4.y; a.z += pv * w4.z; a.w += pv * w4.w; }
              a.x = wave_sum(a.x); a.y = wave_sum(a.y); a.z = wave_sum(a.z); a.w = wave_sum(a.w);
              if (lane == 0) *(f32x4*)(CBIAS + kv * 256 + 4 * nq) = a; }
        }
        { const float* wsrc = args.in[5];
          for (int i = vcu * NWAVES * 64 + tid; i < 8 * 128 * 128; i += G * NWAVES * 64) { const int t = (i >> 7) & 127, sidx = i & 127; WTRI[i] = f2bf(sidx <= t ? wsrc[i] : 0.f); } }
        for (int i = (vcu * NWAVES * 64 + tid); i < SEQ * 32; i += G * NWAVES * 64) { const int pos = i >> 5, f = i & 31;
            double rev = (double)pos * ROPE_REV[f]; rev -= floor(rev); const float rr = (float)rev;
            ropeC[i] = __builtin_amdgcn_cosf(rr); ropeS[i] = __builtin_amdgcn_sinf(rr); }
        for (int m = gw; m < NTOK; m += NGW) rms_row_to_bf16(args.in[0] + (size_t)m * 1024, args.in[2], HN + (size_t)m * 1024, lane);
        { const f32x4* ps = (const f32x4*)args.in[1]; v2u* pd = (v2u*)PBF;
          for (int i = vcu * NWAVES * 64 + tid; i < NTOK * 256 / 4; i += G * NWAVES * 64) { const f32x4 v = ps[i]; v2u o; o.x = pk2(v.x, v.y); o.y = pk2(v.z, v.w); pd[i] = o; } }
        if (BOTH(0)) xcd_barrier(bar);
    }
    if (IN(1)) {
        pg8::Gemm g{HN, WT_IN, NTOK, N_IN_PAD, 1024, 1024, 1024, nullptr}; pg8::StaticOrder S; S.init(NTOK, N_IN_PAD, G, bx);
        EpiIn E{(bf16_t*)(ws + WS_U), (bf16_t*)(ws + WS_V), (bf16_t*)(ws + WS_Q), (bf16_t*)(ws + WS_KV), (float*)(ws + WS_GATES), ropeC, ropeS, (float*)(ws + WS_VSQ)};
        pg8::gemm_phase<EpiIn, pg8::StaticOrder, true, true>(lds, g, S, E);
    }
    if (IN(2)) {
        pg8::Gemm g{PBF, WT_PE, NTOK, 1024, 256, 256, 256, nullptr}; pg8::StaticOrder S; S.init(NTOK, 1024, G, bx);
        EpiBf16N E{PP, 1024, 3};
        pg8::gemm_phase<EpiBf16N, pg8::StaticOrder, false, true>(lds, g, S, E);
        if (BOTH(2)) xcd_barrier(bar);
    }
    if (IN(3)) {
        for (int u = bx; u < 256; u += G) {
            if (u < 128) gmlp_unit(u, (const bf16_t*)(ws + WS_U), (const bf16_t*)(ws + WS_V), (const float*)(ws + WS_VSQ), WTRI, args.in[4], args.in[6], args.in[13], (bf16_t*)(ws + WS_CAT), lds, tid, lane, wave);
            else compress_unit(u - 128, (const bf16_t*)(ws + WS_KV), W1T, W2T, CBIAS, (bf16_t*)(ws + WS_CK), (bf16_t*)(ws + WS_CV), lds, lane, wave);
        }
        if (BOTH(3)) xcd_barrier(bar);
    }
    if (IN(4)) {
        for (int it = bx; it < 256; it += G) { const int b = it & 1, jp = it >> 1;
#pragma unroll 1
            for (int u2 = 0; u2 < 2; ++u2)
                attn_unit(b, u2 ? jp : 255 - jp, (const bf16_t*)(ws + WS_Q), (const bf16_t*)(ws + WS_CK), (const bf16_t*)(ws + WS_CV), (const bf16_t*)(ws + WS_KV + 2 * KV_STRIDE), (const bf16_t*)(ws + WS_KV + 3 * KV_STRIDE),
                          (const bf16_t*)(ws + WS_KV + 4 * KV_STRIDE), (const bf16_t*)(ws + WS_KV + 5 * KV_STRIDE), (const float*)(ws + WS_GATES), args.in[14], (bf16_t*)(ws + WS_CAT), lds, tid, lane, wave); }
        if (BOTH(4)) xcd_barrier(bar);
    }
    if (IN(5)) {
        pg8::Gemm g{(const bf16_t*)(ws + WS_CAT), WT_O, NTOK, 1024, 1024, 1024, 1024, nullptr}; pg8::StaticOrder S; S.init(NTOK, 1024, G, bx);
        EpiWo E{args.in[0], out};
        pg8::gemm_phase<EpiWo, pg8::StaticOrder, false, true>(lds, g, S, E);
        if (BOTH(5)) xcd_barrier(bar);
    }
    if (IN(6)) {
        LAS float* RW = (LAS float*)lds;
        LAS int* lh = (LAS int*)(lds + 20 * 1024 * 4);
        { const float* rg = args.in[17]; const float* re = args.in[18];
          for (int i = tid; i < 1024 * 4; i += NWAVES * 64) RW[(i & 3) * 1024 + (i >> 2)] = rg[i];
          for (int i = tid; i < 1024 * 16; i += NWAVES * 64) RW[(4 + (i & 15)) * 1024 + (i >> 4)] = re[i];
          if (tid < 16) lh[tid] = 0; }
        const float* gmoe = args.in[16];
        for (int ch = bx; ch < NTOK / 64; ch += G) {
        __syncthreads();
        if (tid < 16) lh[tid] = 0;
        __syncthreads();
        for (int ti = 0; ti < 8; ++ti) {
            const int tok = ch * 64 + wave * 8 + ti;
            const f32x4* xr = (const f32x4*)(out + (size_t)tok * 1024) + lane; const f32x4* gr = (const f32x4*)gmoe + lane;
            f32x4 v[4]; float s = 0.f;
#pragma unroll
            for (int j = 0; j < 4; ++j) { v[j] = xr[64 * j]; s += (v[j].x * v[j].x + v[j].y * v[j].y) + (v[j].z * v[j].z + v[j].w * v[j].w); }
            const float r = rsqrtf(wave_sum(s) * (1.f / 1024.f) + EPS);
            v2u* o8 = (v2u*)(HN + (size_t)tok * 1024) + lane;
#pragma unroll
            for (int j = 0; j < 4; ++j) { const f32x4 g4 = gr[64 * j]; v[j].x *= r * g4.x; v[j].y *= r * g4.y; v[j].z *= r * g4.z; v[j].w *= r * g4.w;
                v2u o; o.x = pk2(v[j].x, v[j].y); o.y = pk2(v[j].z, v[j].w); o8[64 * j] = o; }
            float lg[20];
#pragma unroll
            for (int c = 0; c < 20; ++c) { float a = 0.f;
#pragma unroll
                for (int j = 0; j < 4; ++j) { const f32x4 w4 = *(const LAS f32x4*)(RW + c * 1024 + 4 * (lane + 64 * j)); a += (v[j].x * w4.x + v[j].y * w4.y) + (v[j].z * w4.z + v[j].w * w4.w); }
                lg[c] = wave_sum(a); }
            if (lane == 0) {
                int gs = 0; float gm = lg[0];
#pragma unroll
                for (int j = 1; j < 4; ++j) if (lg[j] > gm) { gm = lg[j]; gs = j; }
                float den = 0.f;
#pragma unroll
                for (int j = 0; j < 4; ++j) den += __expf(lg[j] - gm);
                const float pg = 1.0f / den;
                float le[4];
#pragma unroll
                for (int j = 0; j < 4; ++j) le[j] = gs == 0 ? lg[4 + j] : gs == 1 ? lg[8 + j] : gs == 2 ? lg[12 + j] : lg[16 + j];
                float b0 = le[0]; int e0 = 0;
#pragma unroll
                for (int j = 1; j < 4; ++j) if (le[j] > b0) { b0 = le[j]; e0 = j; }
                float b1 = -3.0e38f; int e1 = -1;
#pragma unroll
                for (int j = 0; j < 4; ++j) if (j != e0 && (e1 < 0 || le[j] > b1)) { b1 = le[j]; e1 = j; }
                const float p1 = __expf(b1 - b0);
                const int E0 = gs * 4 + e0, E1 = gs * 4 + e1;
                r_toke[tok * 2] = E0; r_toke[tok * 2 + 1] = E1; r_tokw[tok * 2] = pg / (1.0f + p1); r_tokw[tok * 2 + 1] = pg * p1 / (1.0f + p1);
                atomicAdd((int*)(lh + E0), 1); atomicAdd((int*)(lh + E1), 1);
            }
        }
        __syncthreads();
        if (tid < 16) r_hist[ch * 16 + tid] = lh[tid];
        }
        if (BOTH(6)) xcd_barrier(bar);
    }
    if (IN(7)) {
        LAS int* l_cnt = (LAS int*)lds; LAS int* l_pre = l_cnt + 16; LAS int* l_base = l_cnt + 32;
        for (int ch = bx; ch < NTOK / 64; ch += G) {
        __syncthreads();
        if (tid < 16) { int c = 0, pre = 0; for (int q = 0; q < NTOK / 64; ++q) { const int h = r_hist[q * 16 + tid]; c += h; if (q < ch) pre += h; } l_cnt[tid] = c; l_pre[tid] = pre; }
        __syncthreads();
        if (tid == 0) { int a = 0; for (int e = 0; e < 16; ++e) { l_base[e] = a; a += (l_cnt[e] + 255) & ~255; }
            if (ch == 0) { int rt = 0; for (int e = 0; e < 16; ++e) { const int nt = (l_cnt[e] + 255) >> 8; for (int j = 0; j < nt; ++j) r_tile2e[rt++] = e; } *r_nrt = rt; }
            int run[16];
#pragma unroll
            for (int e = 0; e < 16; ++e) run[e] = 0;
            for (int i = 0; i < 128; ++i) { const int tok = ch * 64 + (i >> 1); const int e = r_toke[tok * 2 + (i & 1)];
                int pos = 0;
#pragma unroll
                for (int q = 0; q < 16; ++q) if (q == e) { pos = run[q]; run[q] = pos + 1; }
                const int slot = l_base[e] + l_pre[e] + pos; r_tokslot[tok * 2 + (i & 1)] = slot; r_slot2tok[slot] = tok; } }
        __syncthreads();
        if (ch < 16) { const int e = ch, c = l_cnt[e], cp = (c + 255) & ~255; for (int s2 = c + tid; s2 < cp; s2 += NWAVES * 64) r_slot2tok[l_base[e] + s2] = 0; }
        }
        if (BOTH(7)) xcd_barrier(bar);
    }
    if (IN(8)) {
        pg8::Gemm g{HN, WT_GU, MAXSLOT, 16 * 1024, 1024, 1024, 1024, r_slot2tok}; MoeOrder S{*r_nrt * 4, G, bx, r_tile2e};
        EpiGU E{HID};
        pg8::gemm_phase<EpiGU, MoeOrder, true, true, true>(lds, g, S, E);
        if (BOTH(8)) xcd_barrier(bar);
    }
    if (IN(9)) {
        pg8::Gemm g{HID, WT_D, MAXSLOT, 16 * 1024, 512, 512, 512, nullptr}; MoeOrder S{*r_nrt * 4, G, bx, r_tile2e};
        EpiBf16N E{YS, 1024, 3};
        pg8::gemm_phase<EpiBf16N, MoeOrder, true, true>(lds, g, S, E);
        if (BOTH(9)) xcd_barrier(bar);
    }
    if (IN(10)) {
        const float* gple = args.in[22];
        for (int tok = gw; tok < NTOK; tok += NGW) {
            const int s0 = r_tokslot[tok * 2], s1 = r_tokslot[tok * 2 + 1]; const float w0 = r_tokw[tok * 2], w1 = r_tokw[tok * 2 + 1];
            f32x4* xr = (f32x4*)(out + (size_t)tok * 1024) + lane; const v2u* y0 = (const v2u*)(YS + (size_t)s0 * 1024) + lane; const v2u* y1 = (const v2u*)(YS + (size_t)s1 * 1024) + lane;
            const f32x4* gr = (const f32x4*)gple + lane;
            f32x4 v[4]; float s = 0.f;
#pragma unroll
            for (int j = 0; j < 4; ++j) { v[j] = xr[64 * j]; const v2u a = y0[64 * j], b = y1[64 * j];
                v[j].x += w0 * __uint_as_float(a.x << 16) + w1 * __uint_as_float(b.x << 16); v[j].y += w0 * __uint_as_float(a.x & 0xffff0000u) + w1 * __uint_as_float(b.x & 0xffff0000u);
                v[j].z += w0 * __uint_as_float(a.y << 16) + w1 * __uint_as_float(b.y << 16); v[j].w += w0 * __uint_as_float(a.y & 0xffff0000u) + w1 * __uint_as_float(b.y & 0xffff0000u);
                xr[64 * j] = v[j]; s += (v[j].x * v[j].x + v[j].y * v[j].y) + (v[j].z * v[j].z + v[j].w * v[j].w); }
            const float r = rsqrtf(wave_sum(s) * (1.f / 1024.f) + EPS);
            v2u* o8 = (v2u*)(HN + (size_t)tok * 1024) + lane;
#pragma unroll
            for (int j = 0; j < 4; ++j) { const f32x4 g4 = gr[64 * j]; v2u o; o.x = pk2(v[j].x * r * g4.x, v[j].y * r * g4.y); o.y = pk2(v[j].z * r * g4.z, v[j].w * r * g4.w); o8[64 * j] = o; }
        }
        if (BOTH(10)) xcd_barrier(bar);
    }
    if (IN(11)) {
        pg8::Gemm g{HN, WT_PG, NTOK, 1024, 1024, 1024, 1024, nullptr}; pg8::StaticOrder S; S.init(NTOK, 1024, G, bx);
        EpiPle E{PP, out};
        pg8::gemm_phase<EpiPle, pg8::StaticOrder, false, true>(lds, g, S, E);
        if (BOTH(11)) xcd_barrier(bar);
    }
    if (IN(12)) {
        const float* gf = args.in[25];
        for (int tok = gw; tok < NTOK; tok += NGW) {
            f32x4* xr = (f32x4*)(out + (size_t)tok * 1024) + lane; const f32x4* gr = (const f32x4*)gf + lane;
            f32x4 v[4]; float s = 0.f;
#pragma unroll
            for (int j = 0; j < 4; ++j) { v[j] = xr[64 * j]; s += (v[j].x * v[j].x + v[j].y * v[j].y) + (v[j].z * v[j].z + v[j].w * v[j].w); }
            const float r = rsqrtf(wave_sum(s) * (1.f / 1024.f) + EPS);
#pragma unroll
            for (int j = 0; j < 4; ++j) { const f32x4 g4 = gr[64 * j]; xr[64 * j] = (f32x4){v[j].x * r * g4.x, v[j].y * r * g4.y, v[j].z * r * g4.z, v[j].w * r * g4.w}; }
        }
    }
#undef IN
#undef BOTH
}


extern "C" void kernel_launch(void* const* d_in, const int* in_sizes, int n_in, void* d_out, int out_size, void* d_ws, size_t ws_size, hipStream_t stream) {
    static int grid = 0;
    if (grid == 0) {
        int dev = 0, cus = 0, per_cu = 0;
        if (hipGetDevice(&dev) != hipSuccess || hipDeviceGetAttribute(&cus, hipDeviceAttributeMultiprocessorCount, dev) != hipSuccess) { fprintf(stderr, "kernel_launch: device query failed\n"); grid = -1; return; }
        if (hipFuncSetAttribute((const void*)mk_fwd, hipFuncAttributeMaxDynamicSharedMemorySize, LDS_BYTES) != hipSuccess) { fprintf(stderr, "kernel_launch: hipFuncSetAttribute failed\n"); grid = -1; return; }
        if (hipOccupancyMaxActiveBlocksPerMultiprocessor(&per_cu, (const void*)mk_fwd, NWAVES * 64, LDS_BYTES) != hipSuccess || per_cu < 1) { fprintf(stderr, "kernel_launch: occupancy query says %d blocks per CU\n", per_cu); (void)hipGetLastError(); grid = -1; return; }
        grid = cus;
    }
    if (grid < 0) return;
    const float* x = (const float*)d_in[0]; const float* p = (const float*)d_in[1];
    const float* g_v = (const float*)d_in[4]; const float* w_s = (const float*)d_in[5]; const float* b_s = (const float*)d_in[6];
    const float* pe_k = (const float*)d_in[7]; const float* w1_k = (const float*)d_in[8]; const float* w2_k = (const float*)d_in[9];
    const float* pe_v = (const float*)d_in[10]; const float* w1_v = (const float*)d_in[11]; const float* w2_v = (const float*)d_in[12];
    const float* g_a = (const float*)d_in[13]; const float* g_b = (const float*)d_in[14]; const float* w_o = (const float*)d_in[15];
    const float* norm_moe = (const float*)d_in[16]; const float* r_g = (const float*)d_in[17]; const float* r_e = (const float*)d_in[18];
    const float* wg = (const float*)d_in[19]; const float* wu = (const float*)d_in[20]; const float* wd = (const float*)d_in[21];
    const float* norm_ple = (const float*)d_in[22]; const float* w_pe = (const float*)d_in[23]; const float* w_pg = (const float*)d_in[24]; const float* norm_final = (const float*)d_in[25];
    float* out = (float*)d_out;
    WS w = make_ws(d_ws);
    (void)hipMemsetAsync((char*)d_ws + WS_CTL, 0, CTL_ZERO_BYTES, stream);
    Args a{};
    for (int i = 0; i < 26; ++i) a.in[i] = (const float*)d_in[i];
    a.out = out; a.ws = (unsigned char*)d_ws;
    a.ph_lo = 0; a.ph_hi = 13; a.li = 0;
    hipLaunchKernelGGL(mk_fwd, dim3(grid), dim3(NWAVES * 64), LDS_BYTES, stream, a);
}
```

```cpp
#include <hip/hip_runtime.h>
#include <cstdint>
#include <cstdio>

constexpr int D_MODEL = 1024, BATCH = 2, SEQ = 8192, NTOK = BATCH * SEQ;
constexpr int HD = 64, A_WIDTH = 512, B_WIDTH = 512, B_KV = 2, KV_W = 128;
constexpr int N_GATES = 24, CHUNK = 128, L_CMP = 32, STRIDE_CMP = 16, CMP_HIDDEN = 256;
constexpr int L_SEL = 64, N_SEL = 16, WIN = 512, NCMP = 511, NCP = 512, NSB = 128;
constexpr int N_EXPERTS = 16, D_FF = 512, D_PLE = 256;
constexpr int OFF_Q = 1024, OFF_KV = 1536, OFF_GATE = 2304, D_IN = 2328;
constexpr int N_IN_PAD = 2560;
constexpr float EPS = 1e-6f;

typedef unsigned short bf16_t;
__device__ __forceinline__ bf16_t f2bf(float f) { unsigned u = __float_as_uint(f); u += 0x7fffu + ((u >> 16) & 1u); return (bf16_t)(u >> 16); }
__device__ __forceinline__ float bf2f(bf16_t h) { return __uint_as_float(((unsigned)h) << 16); }
typedef float f32x2_t_ __attribute__((ext_vector_type(2))); typedef __bf16 bf16x2_t_ __attribute__((ext_vector_type(2)));
__device__ __forceinline__ unsigned pk2(float lo, float hi) { const f32x2_t_ v = {lo, hi}; const bf16x2_t_ b = __builtin_convertvector(v, bf16x2_t_); return __builtin_bit_cast(unsigned, b); }
__device__ __forceinline__ float gelu_tanh(float x) { const float u = 0.7978845608028654f * (x + 0.044715f * x * x * x); return 0.5f * x * (1.0f + tanhf(u)); }
__device__ __forceinline__ float gelu_fast(float x) { const float u = x * (0.7978845608028654f + 0.035677408136300125f * x * x); return x * __builtin_amdgcn_rcpf(1.0f + __builtin_amdgcn_exp2f(-2.8853900817779268f * u)); }
__device__ __forceinline__ float sigmoidf_(float x) { return 1.0f / (1.0f + __expf(-x)); }
__device__ __forceinline__ float wave_sum(float v) {
    v += __uint_as_float(__builtin_amdgcn_update_dpp(0, __float_as_uint(v), 0xB1, 0xf, 0xf, false));
    v += __uint_as_float(__builtin_amdgcn_update_dpp(0, __float_as_uint(v), 0x4E, 0xf, 0xf, false));
    v += __uint_as_float(__builtin_amdgcn_update_dpp(0, __float_as_uint(v), 0x141, 0xf, 0xf, false));
    v += __uint_as_float(__builtin_amdgcn_update_dpp(0, __float_as_uint(v), 0x140, 0xf, 0xf, false));
    v += __uint_as_float(__builtin_amdgcn_ds_swizzle(__float_as_uint(v), 0x401F));
    const auto rr = __builtin_amdgcn_permlane32_swap(__float_as_uint(v), __float_as_uint(v), false, false);
    return __uint_as_float(rr[0]) + __uint_as_float(rr[1]);
}
__device__ __forceinline__ float wave_max(float v) {
#pragma unroll
    for (int o = 32; o > 0; o >>= 1) v = fmaxf(v, __shfl_xor(v, o));
    return v;
}

__device__ const double ROPE_REV[32] = {0.15915494309189535, 0.11934937021124886, 0.08949940160889101, 0.06711508300522726, 0.050329212104487035, 0.03774158471741977, 0.0283021958306234, 0.02122365276477766, 0.015915494309189534, 0.011934937021124886, 0.008949940160889102, 0.006711508300522725, 0.005032921210448704, 0.003774158471741977, 0.00283021958306234, 0.0021223652764777662, 0.0015915494309189536, 0.0011934937021124885, 0.0008949940160889102, 0.0006711508300522726, 0.0005032921210448703, 0.00037741584717419774, 0.00028302195830623395, 0.0002122365276477766, 0.00015915494309189535, 0.00011934937021124886, 8.949940160889102e-05, 6.711508300522725e-05, 5.0329212104487035e-05, 3.774158471741978e-05, 2.8302195830623396e-05, 2.122365276477766e-05};

namespace pg8 {
#define PG8_LAS __attribute__((address_space(3)))
typedef unsigned short bf16_t;
typedef short bf16x8 __attribute__((ext_vector_type(8)));
typedef float f32x4 __attribute__((ext_vector_type(4)));
typedef unsigned u32x4 __attribute__((ext_vector_type(4)));
constexpr int BM = 256, BK = 64, HALF = 128, HTB = HALF * BK * 2  , STAGE_BYTES = 8 * HTB, NXCD = 8, WGM = 8;

__host__ __device__ __forceinline__ int lds_byte(int r, int c) { const int st = (r >> 4) * 2 + (c >> 5), rr = r & 15, cc = c & 31, ob = rr * 64 + cc * 2; return st * 1024 + (ob ^ (((ob >> 9) & 1) << 5)); }
__host__ __device__ __forceinline__ void stage_rc(int b, int& R, int& C) { const int st = b / 1024, sb = b % 1024, swz = sb ^ (((sb >> 9) & 1) << 5); R = (st >> 1) * 16 + swz / 64; C = (st & 1) * 32 + (swz % 64) / 2; }
__host__ __device__ __forceinline__ int perm32(int rho) { const int n = rho >> 4, i = rho & 15; return 8 * (i >> 2) + 4 * n + (i & 3); }

struct Unit { int pm, pn; };
struct Gemm { const bf16_t* A; const bf16_t* Bt; int M, N, K, lda, ldb; const int* rowmap; };

struct StaticOrder {
    int nM, nN, nwg, G, c;
    __host__ __device__ void init(int M, int N, int G_, int c_) { nM = M / BM; nN = N / BM; nwg = nM * nN; G = G_; c = c_; }
    __host__ __device__ bool next(int i, Unit& u) const {
        const long L = (long)i * G + c; if (L >= nwg) return false;
        int wgid = (int)L; { const int q = nwg / NXCD, r = nwg % NXCD, xcd = wgid % NXCD, off = wgid / NXCD; wgid = (xcd < r ? xcd * (q + 1) : r * (q + 1) + (xcd - r) * q) + off; }
        const int nig = WGM * nN, gid = wgid / nig, fm = gid * WGM, gsz = (nM - fm) < WGM ? (nM - fm) : WGM;
        u.pm = fm + ((wgid % nig) % gsz); u.pn = (wgid % nig) / gsz; return true;
    }
    __device__ __forceinline__ void a_ready(const Unit&) const {}
    __device__ __forceinline__ void done(const Unit&) const {}
};

template <class Epi, class Sched, bool ALIGN_EPI = false, bool SP2 = false, bool GATHER = false>
__device__ __forceinline__ void gemm_phase(PG8_LAS unsigned char* lds, const Gemm g, const Sched& S, const Epi& E) {
    const int tid = threadIdx.x, wid = __builtin_amdgcn_readfirstlane(tid >> 6), lane = tid & 63, wr = wid >> 2, wc = wid & 3, fr = lane & 15, fq = lane >> 4;
    const int K = g.K, nt = K / BK;
    unsigned voffA[2], voffB[2];
#pragma unroll
    for (int i = 0; i < 2; ++i) { int R, C; stage_rc(tid * 16 + i * 8192, R, C); const int Rb = Epi::PERM ? ((R & ~31) + perm32(R & 31)) : R;
        voffA[i] = (unsigned)(R * g.lda + C) * 2u; voffB[i] = (unsigned)(Rb * g.ldb + C) * 2u; }
    int gR0 = 0, gR1 = 0, gC0 = 0, gC1 = 0; { int R, C; stage_rc(tid * 16, R, C); gR0 = R; gC0 = C; stage_rc(tid * 16 + 8192, R, C); gR1 = R; gC1 = C; }
    unsigned vgc00 = 0, vgc01 = 0, vgc10 = 0, vgc11 = 0, vgn00 = 0, vgn01 = 0, vgn10 = 0, vgn11 = 0;
#define PG8_LOADVG(u, v00, v01, v10, v11) do { const int* rm_ = g.rowmap + (u).pm * BM; \
        v00 = (unsigned)(rm_[gR0] * g.lda + gC0) * 2u; v01 = (unsigned)(rm_[gR1] * g.lda + gC1) * 2u; \
        v10 = (unsigned)(rm_[HALF + gR0] * g.lda + gC0) * 2u; v11 = (unsigned)(rm_[HALF + gR1] * g.lda + gC1) * 2u; \
        asm volatile("" : "+v"(v00), "+v"(v01), "+v"(v10), "+v"(v11)); } while (0)
#define PG8_STA(b, h, ptr, nextflag) do { if constexpr (GATHER) { unsigned vs_[2]; \
        vs_[0] = (nextflag) ? ((h) ? vgn10 : vgn00) : ((h) ? vgc10 : vgc00); vs_[1] = (nextflag) ? ((h) ? vgn11 : vgn01) : ((h) ? vgc11 : vgc01); \
        PG8_STAGE(PG8_SA(b, h), ptr, vs_); } else { PG8_STAGE(PG8_SA(b, h), (ptr) + ((h) ? hstepA : 0), voffA); } } while (0)
    const size_t kstep = (size_t)(BK * 2);
    const size_t hstepA = (size_t)HALF * g.lda * 2, hstepB = (size_t)HALF * g.ldb * 2;
    const size_t tstepA = 2 * hstepA, tstepB = 2 * hstepB;
    const unsigned ldsw = (unsigned)wid * 1024u;
    const int aoff = lds_byte(wr * 64 + fr, fq * 8), boff = lds_byte(wc * 32 + fr, fq * 8);
#define PG8_SA(b, h) (((b) * 2 + (h)) * HTB)
#define PG8_SB(b, h) ((4 + (b) * 2 + (h)) * HTB)
#define PG8_STAGE(bufoff, gbase, voff) do { _Pragma("unroll") for (int _i = 0; _i < 2; ++_i) \
        __builtin_amdgcn_global_load_lds((const unsigned*)((const char*)(gbase) + (voff)[_i]), (PG8_LAS unsigned*)(lds + (bufoff) + ldsw + _i * 8192), 16, 0, 0); } while (0)
#define PG8_LDA(dst, b, h) do { _Pragma("unroll") for (int m = 0; m < 4; ++m) _Pragma("unroll") for (int k = 0; k < 2; ++k) dst[m][k] = *(const PG8_LAS bf16x8*)(lds + PG8_SA(b, h) + aoff + m * 2048 + k * 1024); } while (0)
#define PG8_LDB(dst, b, h) do { _Pragma("unroll") for (int n = 0; n < 2; ++n) _Pragma("unroll") for (int k = 0; k < 2; ++k) dst[n][k] = *(const PG8_LAS bf16x8*)(lds + PG8_SB(b, h) + boff + n * 2048 + k * 1024); } while (0)
#define PG8_MMA(ai, bj, At, Bt) do { __builtin_amdgcn_s_setprio(1); _Pragma("unroll") for (int m = 0; m < 4; ++m) _Pragma("unroll") for (int n = 0; n < 2; ++n) _Pragma("unroll") for (int k = 0; k < 2; ++k) \
        acc[ai][bj][m][n] = __builtin_amdgcn_mfma_f32_16x16x32_bf16(Bt[n][k], At[m][k], acc[ai][bj][m][n], 0, 0, 0); __builtin_amdgcn_s_setprio(0); } while (0)
#define PG8_WAIT_V(n) asm volatile("s_waitcnt vmcnt(" #n ")" ::: "memory")
#define PG8_WAIT_L(n) asm volatile("s_waitcnt lgkmcnt(" #n ")" ::: "memory")
#define PG8_BAR __builtin_amdgcn_s_barrier()
#define PG8_SCHED __builtin_amdgcn_sched_barrier(0)
    Unit cur, nxt; int ui = 0;
    if (!S.next(0, cur)) return;
    f32x4 acc[2][2][4][2];
#pragma unroll
    for (int a = 0; a < 2; ++a)
#pragma unroll
        for (int b = 0; b < 2; ++b)
#pragma unroll
            for (int m = 0; m < 4; ++m)
#pragma unroll
                for (int n = 0; n < 2; ++n) acc[a][b][m][n] = (f32x4){0.f, 0.f, 0.f, 0.f};
    bf16x8 At[4][2], B0[2][2], B1[2][2];
    const char* cA = (const char*)g.A + (GATHER ? (size_t)0 : (size_t)cur.pm * tstepA); const char* cB = (const char*)g.Bt + (size_t)cur.pn * tstepB;
    if constexpr (GATHER) PG8_LOADVG(cur, vgc00, vgc01, vgc10, vgc11);
    S.a_ready(cur);
    if constexpr (SP2) {
        PG8_STAGE(PG8_SB(0, 0), cB, voffB); PG8_STAGE(PG8_SB(0, 1), cB + hstepB, voffB); PG8_STA(0, 0, cA, false); PG8_STA(0, 1, cA, false);
        if (wr == 1) PG8_BAR;
        PG8_WAIT_V(2); PG8_BAR;
        PG8_STAGE(PG8_SB(1, 0), cB + kstep, voffB); PG8_STA(1, 0, cA + kstep, false); PG8_STAGE(PG8_SB(1, 1), cB + hstepB + kstep, voffB);
        PG8_WAIT_V(6); PG8_BAR;
    } else {
        PG8_STAGE(PG8_SB(0, 0), cB, voffB); PG8_STA(0, 0, cA, false); PG8_STAGE(PG8_SB(0, 1), cB + hstepB, voffB); PG8_STA(0, 1, cA, false);
        if (wr == 1) PG8_BAR;
        PG8_WAIT_V(4); PG8_BAR;
        PG8_STAGE(PG8_SB(1, 0), cB + kstep, voffB); PG8_STA(1, 0, cA + kstep, false); PG8_STAGE(PG8_SB(1, 1), cB + hstepB + kstep, voffB);
        PG8_WAIT_V(6); PG8_BAR;
    }
    for (;;) {
        const bool has_next = S.next(ui + 1, nxt);
        const char* nA = (has_next && !GATHER) ? (const char*)g.A + (size_t)nxt.pm * tstepA : cA; const char* nB = has_next ? (const char*)g.Bt + (size_t)nxt.pn * tstepB : cB;
        if constexpr (GATHER) { if (has_next) PG8_LOADVG(nxt, vgn00, vgn01, vgn10, vgn11); else { vgn00 = vgc00; vgn01 = vgc01; vgn10 = vgc10; vgn11 = vgc11; } }
        for (int t = 0; t < nt; t += 2) {
            const bool last = (t == nt - 2);
            const char* a1 = cA + (size_t)(t + 1) * kstep;
            const char* a2 = last ? nA : cA + (size_t)(t + 2) * kstep; const char* b2 = last ? nB : cB + (size_t)(t + 2) * kstep;
            const char* a3 = a2 + kstep; const char* b3 = b2 + kstep;
            if (last && has_next) S.a_ready(nxt);
            if constexpr (SP2) {
            PG8_LDB(B0, 0, 0); PG8_LDB(B1, 0, 1); PG8_SCHED; PG8_LDA(At, 0, 0); PG8_STA(1, 1, a1, false);
            PG8_WAIT_V(8); PG8_WAIT_L(0); PG8_BAR; PG8_MMA(0, 0, At, B0); PG8_MMA(0, 1, At, B1); PG8_BAR; PG8_SCHED;
            PG8_LDA(At, 0, 1); PG8_STAGE(PG8_SB(0, 0), b2, voffB); PG8_STAGE(PG8_SB(0, 1), b2 + hstepB, voffB); PG8_STA(0, 0, a2, last);
            PG8_WAIT_V(8); PG8_WAIT_L(0); PG8_BAR; PG8_MMA(1, 0, At, B0); PG8_MMA(1, 1, At, B1); PG8_BAR; PG8_SCHED;
            PG8_LDB(B0, 1, 0); PG8_LDB(B1, 1, 1); PG8_SCHED; PG8_LDA(At, 1, 0); PG8_STA(0, 1, a2, last);
            PG8_WAIT_V(8); PG8_WAIT_L(0); PG8_BAR; PG8_MMA(0, 0, At, B0); PG8_MMA(0, 1, At, B1); PG8_BAR; PG8_SCHED;
            PG8_LDA(At, 1, 1); PG8_STAGE(PG8_SB(1, 0), b3, voffB); PG8_STAGE(PG8_SB(1, 1), b3 + hstepB, voffB); PG8_STA(1, 0, a3, last);
            PG8_WAIT_V(8); PG8_WAIT_L(0); PG8_BAR; PG8_MMA(1, 0, At, B0); PG8_MMA(1, 1, At, B1); PG8_BAR; PG8_SCHED;
            } else {
            PG8_LDB(B0, 0, 0); PG8_SCHED; PG8_LDA(At, 0, 0); PG8_STA(1, 1, a1, false);
            PG8_WAIT_L(8); PG8_BAR; PG8_WAIT_L(0); PG8_MMA(0, 0, At, B0); PG8_BAR; PG8_SCHED;
            PG8_LDB(B1, 0, 1); PG8_STAGE(PG8_SB(0, 0), b2, voffB);
            PG8_BAR; PG8_WAIT_L(0); PG8_MMA(0, 1, At, B1); PG8_BAR;
            PG8_LDA(At, 0, 1); PG8_STA(0, 0, a2, last);
            PG8_BAR; PG8_WAIT_L(0); PG8_MMA(1, 0, At, B0); PG8_BAR; PG8_SCHED;
            PG8_STAGE(PG8_SB(0, 1), b2 + hstepB, voffB);
            PG8_WAIT_V(6); PG8_BAR; PG8_MMA(1, 1, At, B1); PG8_BAR;
            PG8_LDB(B0, 1, 0); PG8_SCHED; PG8_LDA(At, 1, 0); PG8_STA(0, 1, a2, last);
            PG8_WAIT_L(8); PG8_BAR; PG8_WAIT_L(0); PG8_MMA(0, 0, At, B0); PG8_BAR; PG8_SCHED;
            PG8_LDB(B1, 1, 1); PG8_STAGE(PG8_SB(1, 0), b3, voffB);
            PG8_BAR; PG8_WAIT_L(0); PG8_MMA(0, 1, At, B1); PG8_BAR;
            PG8_LDA(At, 1, 1); PG8_STA(1, 0, a3, last);
            PG8_BAR; PG8_WAIT_L(0); PG8_MMA(1, 0, At, B0); PG8_BAR; PG8_SCHED;
            PG8_STAGE(PG8_SB(1, 1), b3 + hstepB, voffB);
            PG8_WAIT_V(6); PG8_BAR; PG8_MMA(1, 1, At, B1); PG8_BAR;
            }
        }
        if constexpr (ALIGN_EPI) { if (wr == 0) PG8_BAR; }
        if constexpr (!Epi::AFTER_DRAIN) { E(acc, cur, wr, wc, fr, fq); S.done(cur); }
        if (!has_next) break;
#pragma unroll
        for (int a = 0; a < 2; ++a)
#pragma unroll
            for (int b = 0; b < 2; ++b)
#pragma unroll
                for (int m = 0; m < 4; ++m)
#pragma unroll
                    for (int n = 0; n < 2; ++n) acc[a][b][m][n] = (f32x4){0.f, 0.f, 0.f, 0.f};
        cur = nxt; cA = nA; cB = nB; ++ui; if constexpr (GATHER) { vgc00 = vgn00; vgc01 = vgn01; vgc10 = vgn10; vgc11 = vgn11; }
        if constexpr (ALIGN_EPI) { if (wr == 1) PG8_BAR; }
    }
    PG8_WAIT_V(0);
    if constexpr (!ALIGN_EPI) { if (wr == 0) PG8_BAR; }
    PG8_BAR;
    if constexpr (Epi::AFTER_DRAIN) { E.fused(acc, cur, wr, wc, fr, fq, lds, wid, lane); S.done(cur); }
#undef PG8_SA
#undef PG8_SB
#undef PG8_STAGE
#undef PG8_LDA
#undef PG8_LDB
#undef PG8_MMA
#undef PG8_WAIT_V
#undef PG8_WAIT_L
#undef PG8_BAR
#undef PG8_SCHED
#undef PG8_STA
#undef PG8_LOADVG
}
}

#define GAS __attribute__((address_space(1)))
#define LAS __attribute__((address_space(3)))
#define XB_TMO      128
#define XB_XCNT(j)  (256  + 64 * (j))
#define XB_XSUB(j)  (1280 + 64 * (j))
#define XB_XGEN(j)  (2304 + 64 * (j))
#define XB_TOP      3328
#define XB_TOPGEN   3392
#define XCD_BAR_WORDS 3456
#define XB_SPIN_CAP (1u << 18)

__device__ __forceinline__ unsigned xb_ld(unsigned* p)              { return __hip_atomic_load(p, __ATOMIC_RELAXED, __HIP_MEMORY_SCOPE_AGENT); }
__device__ __forceinline__ unsigned xb_add(unsigned* p, unsigned v) { return __hip_atomic_fetch_add(p, v, __ATOMIC_RELAXED, __HIP_MEMORY_SCOPE_AGENT); }
__device__ __forceinline__ unsigned xb_xcc_id() { return (unsigned)__builtin_amdgcn_s_getreg((3 << 11) | 20) & 0xFu; }
#define XB_SPIN(cond, bar) do { unsigned _sp = 0; while (cond) { __builtin_amdgcn_s_sleep(1); \
    if ((++_sp & 255u) == 0u) { if (xb_ld(&(bar)[XB_TMO])) break; if (_sp > XB_SPIN_CAP) { atomicAdd(&(bar)[XB_TMO], 1u); break; } } } } while (0)

struct XcdBarrier {
    unsigned* bar; unsigned x;
    volatile LAS unsigned* st;
};

__device__ __forceinline__ XcdBarrier xcd_barrier_post(unsigned* bar, volatile LAS unsigned* st) {
    XcdBarrier b; b.bar = bar; b.x = xb_xcc_id(); b.st = st;
    if (threadIdx.x == 0) (void)xb_add(&bar[XB_XCNT(b.x)], 1u);
    return b;
}
__device__ __forceinline__ void xcd_barrier_complete(unsigned* bar, unsigned x, unsigned& nloc, unsigned& nx) {
    const unsigned G = gridDim.x * gridDim.y * gridDim.z;
    unsigned sum, cnt, mine, sp = 0u;
    for (;;) {
        sum = 0u; cnt = 0u; mine = 0u;
#pragma unroll
        for (unsigned j = 0; j < 16; ++j) { const unsigned c = xb_ld(&bar[XB_XCNT(j)]); sum += c; cnt += (c > 0u) ? 1u : 0u; mine = (j == x) ? c : mine; }
        if (sum == G) break;
        __builtin_amdgcn_s_sleep(1);
        if ((++sp & 255u) == 0u) { if (xb_ld(&bar[XB_TMO])) break; if (sp > XB_SPIN_CAP) { atomicAdd(&bar[XB_TMO], 1u); break; } }
    }
    nloc = mine > 0u ? mine : 1u; nx = cnt > 0u ? cnt : 1u;
}

__device__ __forceinline__ void xcd_barrier(const XcdBarrier& b) {
    asm volatile("s_waitcnt vmcnt(0)" ::: "memory");
    __syncthreads();
    if (threadIdx.x == 0) {
        unsigned* bar = b.bar;
        __builtin_amdgcn_s_waitcnt(0);
        unsigned nloc = b.st[0], nx = b.st[1];
        if (nloc == 0u) { xcd_barrier_complete(bar, b.x, nloc, nx); b.st[0] = nloc; b.st[1] = nx; }
        const unsigned old = xb_add(&bar[XB_XSUB(b.x)], 1u);
        const unsigned gen = old / nloc;
        if (old + 1u == (gen + 1u) * nloc) {
            __builtin_amdgcn_fence(__ATOMIC_RELEASE, "agent");
            asm volatile("s_waitcnt vmcnt(0)" ::: "memory");
            const unsigned og = xb_add(&bar[XB_TOP], 1u);
            const unsigned tg = og / nx;
            if (og + 1u == (tg + 1u) * nx) xb_add(&bar[XB_TOPGEN], 1u);
            else XB_SPIN(xb_ld(&bar[XB_TOPGEN]) == tg, bar);
            __builtin_amdgcn_fence(__ATOMIC_ACQUIRE, "agent");
            xb_add(&bar[XB_XGEN(b.x)], 1u);
            asm volatile("s_waitcnt vmcnt(0)" ::: "memory");
        } else {
            XB_SPIN(xb_ld(&bar[XB_XGEN(b.x)]) == gen, bar);
            __builtin_amdgcn_fence(__ATOMIC_ACQUIRE, "agent");
            asm volatile("s_waitcnt vmcnt(0)" ::: "memory");
        }
    }
    __syncthreads();
}

constexpr size_t MiB = 1u << 20, KiB = 1u << 10;
constexpr size_t WS_CTL = 0, CTL_ZERO_BYTES = 1 * MiB;
constexpr size_t WS_ROPEC = 1 * MiB, WS_ROPES = 2 * MiB;
constexpr size_t WS_WT_IN = 3 * MiB;
constexpr size_t WS_HN = 8 * MiB;
constexpr size_t WS_U = 40 * MiB, WS_V = 56 * MiB, WS_Q = 72 * MiB;
constexpr size_t WS_KV = 88 * MiB, KV_STRIDE = 4 * MiB;
constexpr size_t WS_CAT = 114 * MiB;
constexpr size_t WS_YS = 40 * MiB;
constexpr size_t WS_GATES = 112 * MiB;
constexpr size_t WS_OB = 8 * MiB;
constexpr size_t WS_PBF = 114 * MiB;
constexpr size_t WS_HID = 114 * MiB;
constexpr size_t WS_CK = 152 * MiB, WS_CV = 153 * MiB;
constexpr size_t WS_ROUTE = 154 * MiB;
constexpr size_t WS_VSQ = 155 * MiB;
constexpr size_t WS_W1T = 157 * MiB;
constexpr size_t WS_W2T = 159 * MiB;
constexpr size_t WS_CBIAS = 159 * MiB + 128 * KiB;
constexpr size_t WS_WTRI = 159 * MiB + 256 * KiB;
constexpr size_t WS_RWT = 159 * MiB + 512 * KiB;
constexpr size_t WS_HSQ = 156 * MiB;
constexpr size_t WS_WT_GU = 160 * MiB;
constexpr size_t WS_WT_D = 192 * MiB;
constexpr size_t WS_WT_O = 208 * MiB, WS_WT_PG = 210 * MiB, WS_WT_PE = 212 * MiB;
constexpr size_t WS_PP = 213 * MiB;
constexpr size_t WS_END = 245 * MiB;
constexpr int CW_BAR = 4096;
constexpr int MAXSLOT = 2 * NTOK + 16 * 256;
constexpr size_t R_HIST = 0, R_TOKE = 16 * KiB, R_TOKW = 144 * KiB, R_TOKSLOT = 272 * KiB, R_SLOT2TOK = 400 * KiB, R_TILE2E = 544 * KiB, R_NRT = 545 * KiB, R_RSTD = 560 * KiB, R_SLOTRS = 640 * KiB;

struct WS {
    bf16_t *Q; bf16_t* KV[6]; float* GATES; bf16_t* OB; bf16_t* CKV[2]; bf16_t* CAT;
};
static WS make_ws(void* d_ws) {
    WS w; char* p = (char*)d_ws;
    w.Q = (bf16_t*)(p + WS_Q);
    for (int j = 0; j < 6; ++j) w.KV[j] = (bf16_t*)(p + WS_KV + j * KV_STRIDE);
    w.GATES = (float*)(p + WS_GATES); w.OB = (bf16_t*)(p + WS_OB);
    w.CKV[0] = (bf16_t*)(p + WS_CK); w.CKV[1] = (bf16_t*)(p + WS_CV);
    w.CAT = (bf16_t*)(p + WS_CAT);
    return w;
}

constexpr int RING_BYTES = 131072;
constexpr int LDSCTL_OFF = RING_BYTES;
constexpr int LDS_BYTES = 147456;
constexpr int NWAVES = 8;

typedef unsigned v4u __attribute__((ext_vector_type(4)));
typedef unsigned v2u __attribute__((ext_vector_type(2)));
typedef float f32x4 __attribute__((ext_vector_type(4)));
#define LDS_WAIT() asm volatile("s_waitcnt lgkmcnt(0)" ::: "memory")
#define VM_WAIT() asm volatile("s_waitcnt vmcnt(0)" ::: "memory")

__device__ __forceinline__ bool in_group_is_rope(int G) { return (G >= 8 && G < 12) || G == 12 || G == 14 || G == 16; }
__device__ __forceinline__ int in_dest_row(int c) {
    const int G = c >> 7, lo = c & 127; int wc, n, fq, i = lo & 3;
    if (in_group_is_rope(G)) { const int hd = lo >> 6; n = (lo >> 5) & 1; const int wcl = (lo >> 4) & 1; fq = (lo >> 2) & 3; wc = 2 * hd + wcl; }
    else { wc = lo >> 5; fq = (lo >> 3) & 3; n = (lo >> 2) & 1; }
    return (G << 7) + 32 * wc + 16 * n + 4 * fq + i;
}
template <class F>
__device__ __forceinline__ void p0_transpose_item(const float* W, int ldw, int ncols, bf16_t* WT, int ldt, F dest, LAS float* scr, int k0, int n0, int lane) {
#pragma unroll 8
    for (int i = 0; i < 32; ++i) { const int kk = 2 * i + (lane >> 5), col = n0 + (lane & 31); scr[kk * 33 + (lane & 31)] = (col < ncols) ? W[(size_t)(k0 + kk) * ldw + col] : 0.f; }
    LDS_WAIT(); asm volatile("" ::: "memory");
    const int c = lane & 7;
#pragma unroll
    for (int j = 0; j < 4; ++j) { const int n = (lane >> 3) + 8 * j; const LAS float* s = scr + (8 * c) * 33 + n;
        v4u o; o.x = pk2(s[0 * 33], s[1 * 33]); o.y = pk2(s[2 * 33], s[3 * 33]); o.z = pk2(s[4 * 33], s[5 * 33]); o.w = pk2(s[6 * 33], s[7 * 33]);
        *(v4u*)(WT + (size_t)dest(n0 + n) * ldt + k0 + 8 * c) = o; }
    LDS_WAIT(); asm volatile("" ::: "memory");
}
__device__ __forceinline__ void rms_row_to_bf16(const float* xrow, const float* gain, bf16_t* orow, int lane) {
    const f32x4* xr = (const f32x4*)xrow + lane; const f32x4* gr = (const f32x4*)gain + lane;
    f32x4 v[4]; float s = 0.f;
#pragma unroll
    for (int j = 0; j < 4; ++j) { v[j] = xr[64 * j]; s += (v[j].x * v[j].x + v[j].y * v[j].y) + (v[j].z * v[j].z + v[j].w * v[j].w); }
    const float r = rsqrtf(wave_sum(s) * (1.f / 1024.f) + EPS);
    v2u* o8 = (v2u*)orow + lane;
#pragma unroll
    for (int j = 0; j < 4; ++j) { const f32x4 g = gr[64 * j]; v2u o; o.x = pk2(v[j].x * r * g.x, v[j].y * r * g.y); o.y = pk2(v[j].z * r * g.z, v[j].w * r * g.w); o8[64 * j] = o; }
}

struct EpiIn {
    static constexpr bool PERM = false, AFTER_DRAIN = false;
    bf16_t *U, *V, *Q, *KV0; float* GATES; const float *rC, *rS; float* VSQ;
    __device__ __forceinline__ void operator()(const pg8::f32x4 (&acc)[2][2][4][2], const pg8::Unit& u, int wr, int wc, int fr, int fq) const {
#pragma unroll
        for (int bj = 0; bj < 2; ++bj) {
            const int G = 2 * u.pn + bj;
            if (G > 18) continue;
#pragma unroll
            for (int ai = 0; ai < 2; ++ai)
#pragma unroll
                for (int m = 0; m < 4; ++m) {
                    const int r = u.pm * 256 + ai * 128 + wr * 64 + m * 16 + fr;
                    const pg8::f32x4 v0 = acc[ai][bj][m][0], v1 = acc[ai][bj][m][1];
                    if (G < 4) {
                        v4u o; o.x = pk2(gelu_fast(v0[0]), gelu_fast(v0[1])); o.y = pk2(gelu_fast(v0[2]), gelu_fast(v0[3])); o.z = pk2(gelu_fast(v1[0]), gelu_fast(v1[1])); o.w = pk2(gelu_fast(v1[2]), gelu_fast(v1[3]));
                        *(v4u*)(U + (size_t)r * 512 + G * 128 + 32 * wc + 8 * fq) = o;
                    } else if (G < 8) {
                        float gq[8]; float ssq = 0.f;
#pragma unroll
                        for (int i = 0; i < 4; ++i) { gq[i] = gelu_fast(v0[i]); gq[4 + i] = gelu_fast(v1[i]); ssq += gq[i] * gq[i] + gq[4 + i] * gq[4 + i]; }
                        ssq += __shfl_xor(ssq, 16); ssq += __shfl_xor(ssq, 32);
                        if (fq == 0) VSQ[(size_t)r * 16 + (G - 4) * 4 + wc] = ssq;
                        bf16_t* dst = V + ((size_t)(r >> 7) * 512 + (G - 4) * 128 + 32 * wc + 8 * fq) * 128 + (r & 127);
#pragma unroll
                        for (int i = 0; i < 8; ++i) dst[i * 128] = f2bf(gq[i]);
                    } else if (G == 18) {
                        if (wc == 0 && fq < 3) { float* dst = GATES + (size_t)r * 24 + 8 * fq;
                            *(f32x4*)dst = (f32x4){sigmoidf_(v0[0]), sigmoidf_(v0[1]), sigmoidf_(v0[2]), sigmoidf_(v0[3])};
                            *(f32x4*)(dst + 4) = (f32x4){sigmoidf_(v1[0]), sigmoidf_(v1[1]), sigmoidf_(v1[2]), sigmoidf_(v1[3])}; }
                    } else if (G < 12 || ((G - 12) & 1) == 0) {
                        const int t = r & (SEQ - 1), b = r >> 13, dd = 16 * (wc & 1) + 4 * fq;
                        const f32x4 cs = *(const f32x4*)(rC + t * 32 + dd), sn = *(const f32x4*)(rS + t * 32 + dd);
                        const float sc = (G < 12) ? 0.125f : 1.0f;
                        float o1[4], o2[4];
#pragma unroll
                        for (int i = 0; i < 4; ++i) { o1[i] = (v0[i] * cs[i] - v1[i] * sn[i]) * sc; o2[i] = (v0[i] * sn[i] + v1[i] * cs[i]) * sc; }
                        bf16_t* dst = (G < 12) ? Q + (size_t)r * 512 + (2 * (G - 8) + (wc >> 1)) * 64 + dd
                                               : KV0 + (size_t)(G - 12) * (KV_STRIDE / 2) + ((size_t)(b * 2 + (wc >> 1)) * SEQ + t) * 64 + dd;
                        v2u a; a.x = pk2(o1[0], o1[1]); a.y = pk2(o1[2], o1[3]); *(v2u*)dst = a;
                        v2u c; c.x = pk2(o2[0], o2[1]); c.y = pk2(o2[2], o2[3]); *(v2u*)(dst + 32) = c;
                    } else if (G == 13) {
                        const int t = r & (SEQ - 1), b = r >> 13;
                        bf16_t* dst = KV0 + (size_t)(G - 12) * (KV_STRIDE / 2) + ((size_t)(b * 2 + (wc >> 1)) * SEQ + t) * 64 + ((32 * wc + 8 * fq) & 63);
                        v4u o; o.x = pk2(v0[0], v0[1]); o.y = pk2(v0[2], v0[3]); o.z = pk2(v1[0], v1[1]); o.w = pk2(v1[2], v1[3]);
                        *(v4u*)dst = o;
                    } else {
                        const int t = r & (SEQ - 1), b = r >> 13, t16 = t & 15, pt = (t & ~15) + (t16 & 3) + (((t16 >> 2) & 1) << 3) + (((t16 >> 3) & 1) << 2);
                        bf16_t* dst = KV0 + (size_t)(G - 12) * (KV_STRIDE / 2) + ((size_t)(b * 2 + (wc >> 1)) * 64 + ((32 * wc + 8 * fq) & 63)) * SEQ + pt;
#pragma unroll
                        for (int i = 0; i < 4; ++i) { dst[(size_t)i * SEQ] = f2bf(v0[i]); dst[(size_t)(4 + i) * SEQ] = f2bf(v1[i]); }
                    }
                }
        }
    }
};

__device__ __forceinline__ int nat_dest_row(int c) { const int lo = c & 127; return (c & ~127) + 32 * (lo >> 5) + 16 * ((lo >> 2) & 1) + 4 * ((lo >> 3) & 3) + (lo & 3); }
__device__ __forceinline__ int gu_dest_row(int j) { const int jl = j & 63; return 128 * (j >> 6) + 32 * (jl >> 4) + 4 * ((jl >> 2) & 3) + (jl & 3); }

struct EpiBf16N {
    static constexpr bool PERM = false, AFTER_DRAIN = false;
    bf16_t* O; int ldc; int pn_mask;
    __device__ __forceinline__ void operator()(const pg8::f32x4 (&acc)[2][2][4][2], const pg8::Unit& u, int wr, int wc, int fr, int fq) const {
        const int col0 = (u.pn & pn_mask) * 256 + 32 * wc + 8 * fq;
#pragma unroll
        for (int ai = 0; ai < 2; ++ai)
#pragma unroll
            for (int m = 0; m < 4; ++m) { bf16_t* rowp = O + (size_t)(u.pm * 256 + ai * 128 + wr * 64 + m * 16 + fr) * ldc + col0;
#pragma unroll
                for (int bj = 0; bj < 2; ++bj) { const pg8::f32x4 v0 = acc[ai][bj][m][0], v1 = acc[ai][bj][m][1];
                    v4u o; o.x = pk2(v0[0], v0[1]); o.y = pk2(v0[2], v0[3]); o.z = pk2(v1[0], v1[1]); o.w = pk2(v1[2], v1[3]); *(v4u*)(rowp + bj * 128) = o; } }
    }
};
struct EpiWo {
    static constexpr bool PERM = false, AFTER_DRAIN = false;
    const float* X; float* O; bf16_t* HN2; const float* gmoe; float* HSQ;
    __device__ __forceinline__ void operator()(const pg8::f32x4 (&acc)[2][2][4][2], const pg8::Unit& u, int wr, int wc, int fr, int fq) const {
        const int col0 = u.pn * 256 + 32 * wc + 8 * fq;
        f32x4 gm[2][2];
#pragma unroll
        for (int bj = 0; bj < 2; ++bj) { gm[bj][0] = *(const f32x4*)(gmoe + col0 + bj * 128); gm[bj][1] = *(const f32x4*)(gmoe + col0 + bj * 128 + 4); }
#pragma unroll
        for (int ai = 0; ai < 2; ++ai)
#pragma unroll
            for (int m = 0; m < 4; ++m) { const int r = u.pm * 256 + ai * 128 + wr * 64 + m * 16 + fr; const size_t off = (size_t)r * 1024 + col0; float q = 0.f;
#pragma unroll
                for (int bj = 0; bj < 2; ++bj) { const f32x4 x0 = *(const f32x4*)(X + off + bj * 128), x1 = *(const f32x4*)(X + off + bj * 128 + 4);
                    const f32x4 h0 = x0 + acc[ai][bj][m][0], h1v = x1 + acc[ai][bj][m][1];
                    *(f32x4*)(O + off + bj * 128) = h0; *(f32x4*)(O + off + bj * 128 + 4) = h1v;
                    q += (h0.x * h0.x + h0.y * h0.y) + (h0.z * h0.z + h0.w * h0.w) + (h1v.x * h1v.x + h1v.y * h1v.y) + (h1v.z * h1v.z + h1v.w * h1v.w);
                    v4u o; o.x = pk2(h0.x * gm[bj][0].x, h0.y * gm[bj][0].y); o.y = pk2(h0.z * gm[bj][0].z, h0.w * gm[bj][0].w); o.z = pk2(h1v.x * gm[bj][1].x, h1v.y * gm[bj][1].y); o.w = pk2(h1v.z * gm[bj][1].z, h1v.w * gm[bj][1].w);
                    *(v4u*)(HN2 + off + bj * 128) = o; }
                q += __uint_as_float(__builtin_amdgcn_ds_swizzle(__float_as_uint(q), 0x401F));
                { const auto rr = __builtin_amdgcn_permlane32_swap(__float_as_uint(q), __float_as_uint(q), false, false); q = __uint_as_float(rr[0]) + __uint_as_float(rr[1]); }
                if (fq == 0) HSQ[(size_t)r * 16 + u.pn * 4 + wc] = q; }
    }
};
struct EpiGU {
    static constexpr bool PERM = false, AFTER_DRAIN = false;
    bf16_t* H; const float* slotrs;
    __device__ __forceinline__ void operator()(const pg8::f32x4 (&acc)[2][2][4][2], const pg8::Unit& u, int wr, int wc, int fr, int fq) const {
        const int col0 = (u.pn & 3) * 128 + 16 * wc + 4 * fq;
#pragma unroll
        for (int ai = 0; ai < 2; ++ai)
#pragma unroll
            for (int m = 0; m < 4; ++m) { const int row = u.pm * 256 + ai * 128 + wr * 64 + m * 16 + fr; const float rs = slotrs[row]; bf16_t* rowp = H + (size_t)row * 512 + col0;
#pragma unroll
                for (int bj = 0; bj < 2; ++bj) { const pg8::f32x4 a = acc[ai][bj][m][0] * rs, b = acc[ai][bj][m][1] * rs; float h[4];
#pragma unroll
                    for (int i = 0; i < 4; ++i) h[i] = a[i] * __builtin_amdgcn_rcpf(1.0f + __builtin_amdgcn_exp2f(-1.4426950408889634f * a[i])) * b[i];
                    v2u o; o.x = pk2(h[0], h[1]); o.y = pk2(h[2], h[3]); *(v2u*)(rowp + bj * 64) = o; } }
    }
};
struct EpiPle {
    static constexpr bool PERM = false, AFTER_DRAIN = false;
    const bf16_t* PP; float* O;
    __device__ __forceinline__ void operator()(const pg8::f32x4 (&acc)[2][2][4][2], const pg8::Unit& u, int wr, int wc, int fr, int fq) const {
        const int col0 = u.pn * 256 + 32 * wc + 8 * fq;
#pragma unroll
        for (int ai = 0; ai < 2; ++ai)
#pragma unroll
            for (int m = 0; m < 4; ++m) { const size_t off = (size_t)(u.pm * 256 + ai * 128 + wr * 64 + m * 16 + fr) * 1024 + col0;
#pragma unroll
                for (int bj = 0; bj < 2; ++bj) { const v4u pp = *(const v4u*)(PP + off + bj * 128);
                    f32x4 o0 = *(const f32x4*)(O + off + bj * 128), o1 = *(const f32x4*)(O + off + bj * 128 + 4);
                    const pg8::f32x4 g0 = acc[ai][bj][m][0], g1 = acc[ai][bj][m][1];
                    const float p_[8] = {__uint_as_float(pp.x << 16), __uint_as_float(pp.x & 0xffff0000u), __uint_as_float(pp.y << 16), __uint_as_float(pp.y & 0xffff0000u),
                                         __uint_as_float(pp.z << 16), __uint_as_float(pp.z & 0xffff0000u), __uint_as_float(pp.w << 16), __uint_as_float(pp.w & 0xffff0000u)};
#pragma unroll
                    for (int i = 0; i < 4; ++i) { o0[i] += p_[i] * __builtin_amdgcn_rcpf(1.0f + __builtin_amdgcn_exp2f(-1.4426950408889634f * g0[i]));
                                                  o1[i] += p_[4 + i] * __builtin_amdgcn_rcpf(1.0f + __builtin_amdgcn_exp2f(-1.4426950408889634f * g1[i])); }
                    *(f32x4*)(O + off + bj * 128) = o0; *(f32x4*)(O + off + bj * 128 + 4) = o1; } }
    }
};
struct MoeOrder {
    int nun, G, c; const int* tile2e;
    __device__ bool next(int i, pg8::Unit& u) const {
        const long L = (long)i * G + c; if (L >= nun) return false;
        int wgid = (int)L; { const int q = nun / 8, r = nun % 8, xcd = wgid % 8, off = wgid / 8; wgid = (xcd < r ? xcd * (q + 1) : r * (q + 1) + (xcd - r) * q) + off; }
        u.pm = wgid >> 2; u.pn = tile2e[u.pm] * 4 + (wgid & 3); return true;
    }
    __device__ __forceinline__ void a_ready(const pg8::Unit&) const {}
    __device__ __forceinline__ void done(const pg8::Unit&) const {}
};

typedef short bf16x8 __attribute__((ext_vector_type(8)));
typedef float f32x16 __attribute__((ext_vector_type(16)));
__device__ __forceinline__ float bflo(unsigned u) { return __uint_as_float(u << 16); }
__device__ __forceinline__ float bfhi(unsigned u) { return __uint_as_float(u & 0xffff0000u); }

__device__ __forceinline__ void gmlp_unit(int bc, const bf16_t* __restrict__ U, const bf16_t* __restrict__ VT, const float* __restrict__ VSQ, const bf16_t* __restrict__ WTRI,
                                          const float* __restrict__ g_v, const float* __restrict__ b_s, const float* __restrict__ g_a, bf16_t* CAT, LAS unsigned char* lds, int tid, int lane, int wave) {
    LAS float* rstd = (LAS float*)lds;
    LAS float* osq = rstd + 128;
    const int tok0 = bc * 128, g = wave, fr = lane & 15, fq = lane >> 4;
    __syncthreads();
    if (tid < 128) { const f32x4* q4 = (const f32x4*)(VSQ + (size_t)(tok0 + tid) * 16); const f32x4 a = q4[0], b = q4[1], c = q4[2], d = q4[3];
        const float sm = ((a.x + a.y) + (a.z + a.w)) + ((b.x + b.y) + (b.z + b.w)) + ((c.x + c.y) + (c.z + c.w)) + ((d.x + d.y) + (d.z + d.w));
        rstd[tid] = rsqrtf(sm * (1.f / 512.f) + EPS); }
    __syncthreads();
    const bf16_t* VTc = VT + (size_t)bc * 512 * 128 + (size_t)(64 * g) * 128;
    const bf16_t* Wg = WTRI + (size_t)g * 128 * 128;
#pragma unroll 1
    for (int half = 0; half < 2; ++half) {
    pg8::f32x4 oa[4][4]; float sq[4];
#pragma unroll
    for (int jj = 0; jj < 4; ++jj) {
        const int j = 4 * half + jj;
        pg8::f32x4 acc[4];
#pragma unroll
        for (int dt = 0; dt < 4; ++dt) acc[dt] = (pg8::f32x4){0.f, 0.f, 0.f, 0.f};
#pragma unroll
        for (int ks = 0; ks < 4; ++ks) { if (ks >= (16 * (4 * half + jj) + 16 + 31) / 32) break;
            const int s0 = 32 * ks + 8 * fq;
            const v4u wraw = *(const v4u*)(Wg + (16 * j + fr) * 128 + s0);
            const f32x4 r0 = *(const LAS f32x4*)(rstd + s0), r1 = *(const LAS f32x4*)(rstd + s0 + 4);
            v4u wsc; wsc.x = pk2(bflo(wraw.x) * r0.x, bfhi(wraw.x) * r0.y); wsc.y = pk2(bflo(wraw.y) * r0.z, bfhi(wraw.y) * r0.w);
            wsc.z = pk2(bflo(wraw.z) * r1.x, bfhi(wraw.z) * r1.y); wsc.w = pk2(bflo(wraw.w) * r1.z, bfhi(wraw.w) * r1.w);
            const bf16x8 wb = __builtin_bit_cast(bf16x8, wsc);
#pragma unroll
            for (int dt = 0; dt < 4; ++dt) { const bf16x8 a = *(const bf16x8*)(VTc + (16 * dt + fr) * 128 + s0); acc[dt] = __builtin_amdgcn_mfma_f32_16x16x32_bf16(a, wb, acc[dt], 0, 0, 0); }
        }
        const int t = 16 * j + fr; const size_t tok = (size_t)(tok0 + t); const float bias = b_s[g * 128 + t]; float q = 0.f;
#pragma unroll
        for (int dt = 0; dt < 4; ++dt) { const int col = 64 * g + 16 * dt + 4 * fq; const v2u u2 = *(const v2u*)(U + tok * 512 + col); const f32x4 gv = *(const f32x4*)(g_v + col);
            pg8::f32x4 o; o[0] = bflo(u2.x) * (gv.x * acc[dt][0] + bias); o[1] = bfhi(u2.x) * (gv.y * acc[dt][1] + bias); o[2] = bflo(u2.y) * (gv.z * acc[dt][2] + bias); o[3] = bfhi(u2.y) * (gv.w * acc[dt][3] + bias);
            oa[jj][dt] = o; q += (o[0] * o[0] + o[1] * o[1]) + (o[2] * o[2] + o[3] * o[3]); }
        q += __shfl_xor(q, 16); q += __shfl_xor(q, 32); sq[jj] = q;
    }
#pragma unroll
    for (int jj = 0; jj < 4; ++jj) if (fq == 0) osq[g * 128 + 16 * (4 * half + jj) + fr] = sq[jj];
    __syncthreads();
#pragma unroll
    for (int jj = 0; jj < 4; ++jj) { const int t = 16 * (4 * half + jj) + fr; float sm = 0.f;
#pragma unroll
        for (int gg = 0; gg < 8; ++gg) sm += osq[gg * 128 + t];
        const float ra = rsqrtf(sm * (1.f / 512.f) + EPS); const size_t tok = (size_t)(tok0 + t);
#pragma unroll
        for (int dt = 0; dt < 4; ++dt) { const int col = 64 * g + 16 * dt + 4 * fq; const f32x4 ga = *(const f32x4*)(g_a + col); const pg8::f32x4 o = oa[jj][dt];
            v2u w; w.x = pk2(o[0] * ra * ga.x, o[1] * ra * ga.y); w.y = pk2(o[2] * ra * ga.z, o[3] * ra * ga.w); *(v2u*)(CAT + tok * 1024 + col) = w; } }
    }
}

constexpr int HSTR = 528;
__device__ __forceinline__ void compress_unit(int cu, const bf16_t* __restrict__ KVX, const bf16_t* __restrict__ W1T, const bf16_t* __restrict__ W2T, const float* __restrict__ CBIAS,
                                              bf16_t* CK, bf16_t* CVp, LAS unsigned char* lds, int lane, int wave) {
    asm volatile("" : "+v"(lane));
    const int kv = cu >> 6, bg = (cu >> 4) & 3, c0 = (cu & 15) * 32;
    const bf16_t* X = KVX + (size_t)kv * (KV_STRIDE / 2) + (size_t)bg * SEQ * 64;
    const bf16_t* w1t = W1T + (size_t)kv * 256 * 2048; const bf16_t* w2t = W2T + (size_t)kv * 64 * 256; const float* bias = CBIAS + kv * 256;
    const int r32 = lane & 31, h = lane >> 5, n0 = 32 * wave;
    const bf16_t* ap = w1t + (size_t)(n0 + r32) * 2048 + 8 * h; const bf16_t* bp = X + (size_t)(c0 + r32) * 1024 + 8 * h;
    f32x16 acc;
#pragma unroll
    for (int i = 0; i < 16; ++i) acc[i] = 0.f;
    (void)ap; (void)bp;
    LAS unsigned char* wl = lds + 16896 + wave * 9216;
    const int sr_ = lane >> 3, sc_ = lane & 7;
    const bf16_t* ag = w1t + (size_t)(n0 + sr_) * 2048 + 8 * sc_; const bf16_t* xg = X + (size_t)(c0 + sr_) * 1024 + 8 * sc_;
    LAS unsigned char* wst = wl + sr_ * 144 + sc_ * 16; LAS unsigned char* wrd = wl + r32 * 144 + h * 16;
    v4u pa[4], px[4];
#pragma unroll
    for (int i = 0; i < 4; ++i) { pa[i] = *(const v4u*)(ag + (size_t)(8 * i) * 2048); px[i] = *(const v4u*)(xg + (size_t)(8 * i) * 1024); }
#pragma unroll 1
    for (int kc = 0; kc < 32; ++kc) {
#pragma unroll
        for (int i = 0; i < 4; ++i) { *(LAS v4u*)(wst + i * 8 * 144) = pa[i]; *(LAS v4u*)(wst + 4608 + i * 8 * 144) = px[i]; }
        if (kc + 1 < 32) {
#pragma unroll
            for (int i = 0; i < 4; ++i) { pa[i] = *(const v4u*)(ag + (size_t)(8 * i) * 2048 + 64 * (kc + 1)); px[i] = *(const v4u*)(xg + (size_t)(8 * i) * 1024 + 64 * (kc + 1)); } }
#pragma unroll
        for (int s = 0; s < 4; ++s) { const bf16x8 a = *(const LAS bf16x8*)(wrd + 32 * s); const bf16x8 b = *(const LAS bf16x8*)(wrd + 4608 + 32 * s); acc = __builtin_amdgcn_mfma_f32_32x32x16_bf16(a, b, acc, 0, 0, 0); }
    }
    __syncthreads();
#pragma unroll
    for (int rg = 0; rg < 4; ++rg) { const int n = n0 + 8 * rg + 4 * h; const f32x4 bv = *(const f32x4*)(bias + n);
        v2u w; w.x = pk2(gelu_fast(acc[4 * rg] + bv.x), gelu_fast(acc[4 * rg + 1] + bv.y)); w.y = pk2(gelu_fast(acc[4 * rg + 2] + bv.z), gelu_fast(acc[4 * rg + 3] + bv.w));
        *(LAS v2u*)(lds + r32 * HSTR + n * 2) = w; }
    __syncthreads();
    if (wave < 2) {
        f32x16 o;
#pragma unroll
        for (int i = 0; i < 16; ++i) o[i] = 0.f;
        const bf16_t* wp = w2t + (size_t)(32 * wave + r32) * 256 + 8 * h; LAS unsigned char* hp = lds + r32 * HSTR + 16 * h;
        if (kv == 0) {
#pragma unroll
            for (int s = 0; s < 16; ++s) { const bf16x8 a = *(const bf16x8*)(wp + 16 * s); const bf16x8 b = *(const LAS bf16x8*)(hp + 32 * s); o = __builtin_amdgcn_mfma_f32_32x32x16_bf16(a, b, o, 0, 0, 0); }
            bf16_t* dst = CK + ((size_t)bg * NCP + c0 + r32) * 64 + 32 * wave + 4 * h;
#pragma unroll
            for (int rg = 0; rg < 4; ++rg) { v2u w; w.x = pk2(o[4 * rg], o[4 * rg + 1]); w.y = pk2(o[4 * rg + 2], o[4 * rg + 3]); *(v2u*)(dst + 8 * rg) = w; }
        } else {
#pragma unroll
            for (int s = 0; s < 16; ++s) { const bf16x8 a = *(const LAS bf16x8*)(hp + 32 * s); const bf16x8 b = *(const bf16x8*)(wp + 16 * s); o = __builtin_amdgcn_mfma_f32_32x32x16_bf16(a, b, o, 0, 0, 0); }
            bf16_t* dst = CVp + ((size_t)bg * 64 + 32 * wave + r32) * NCP + c0 + 8 * h;
#pragma unroll
            for (int rg = 0; rg < 4; ++rg) { v2u w; w.x = pk2(o[4 * rg], o[4 * rg + 1]); w.y = pk2(o[4 * rg + 2], o[4 * rg + 3]); *(v2u*)(dst + 16 * (rg >> 1) + 4 * (rg & 1)) = w; }
        }
    }
}

constexpr float L2E = 1.4426950408889634f, MASKV = -3.0e38f, MINIT = -1.0e30f;
constexpr int AT_ROW = 144, AT_TILE = 64 * AT_ROW;
constexpr int AT_IMP = 8 * AT_TILE, AT_SELM = AT_IMP + 32768, AT_OBSQ = AT_SELM + 1024;
__device__ __forceinline__ int at_tile_off(int bufi, int g, int kv) { return ((bufi * 2 + g) * 2 + kv) * AT_TILE; }
__device__ __forceinline__ bf16x8 at_frag(LAS unsigned char* lanebase, int rowoff, int ch) { return *(const LAS bf16x8*)(lanebase + rowoff * AT_ROW + ch * 32); }
__device__ __forceinline__ float xh_sum(float x) { const auto rr = __builtin_amdgcn_permlane32_swap(__float_as_uint(x), __float_as_uint(x), false, false); return __uint_as_float(rr[0]) + __uint_as_float(rr[1]); }
__device__ __forceinline__ float xh_max(float x) { const auto rr = __builtin_amdgcn_permlane32_swap(__float_as_uint(x), __float_as_uint(x), false, false); return fmaxf(__uint_as_float(rr[0]), __uint_as_float(rr[1])); }
__device__ __forceinline__ float quad_sum(float x) { x += __uint_as_float(__builtin_amdgcn_update_dpp(0, __float_as_uint(x), 0xB1, 0xf, 0xf, false)); x += __uint_as_float(__builtin_amdgcn_update_dpp(0, __float_as_uint(x), 0x4E, 0xf, 0xf, false)); return x; }
__device__ __forceinline__ int at_key(int mt, int r, int h) { return 32 * mt + (r & 3) + 8 * (r >> 2) + 4 * h; }

__device__ __forceinline__ void at_qk(LAS unsigned char* kl, const bf16x8 (&qf)[4], f32x16& S0, f32x16& S1) {
    const f32x16 z = {0.f, 0.f, 0.f, 0.f, 0.f, 0.f, 0.f, 0.f, 0.f, 0.f, 0.f, 0.f, 0.f, 0.f, 0.f, 0.f};
    { const bf16x8 a0 = at_frag(kl, 0, 0), a1 = at_frag(kl, 32, 0);
      S0 = __builtin_amdgcn_mfma_f32_32x32x16_bf16(a0, qf[0], z, 0, 0, 0); S1 = __builtin_amdgcn_mfma_f32_32x32x16_bf16(a1, qf[0], z, 0, 0, 0); }
#pragma unroll
    for (int s = 1; s < 4; ++s) { const bf16x8 a0 = at_frag(kl, 0, s), a1 = at_frag(kl, 32, s);
        S0 = __builtin_amdgcn_mfma_f32_32x32x16_bf16(a0, qf[s], S0, 0, 0, 0); S1 = __builtin_amdgcn_mfma_f32_32x32x16_bf16(a1, qf[s], S1, 0, 0, 0); }
}
__device__ __forceinline__ void at_pv(LAS unsigned char* vl, const f32x16& S0, const f32x16& S1, f32x16 (&O)[2]) {
    bf16x8 pf[4];
#pragma unroll
    for (int s = 0; s < 2; ++s) { v4u a, b;
        a.x = pk2(S0[8 * s], S0[8 * s + 1]); a.y = pk2(S0[8 * s + 2], S0[8 * s + 3]); a.z = pk2(S0[8 * s + 4], S0[8 * s + 5]); a.w = pk2(S0[8 * s + 6], S0[8 * s + 7]);
        b.x = pk2(S1[8 * s], S1[8 * s + 1]); b.y = pk2(S1[8 * s + 2], S1[8 * s + 3]); b.z = pk2(S1[8 * s + 4], S1[8 * s + 5]); b.w = pk2(S1[8 * s + 6], S1[8 * s + 7]);
        pf[s] = __builtin_bit_cast(bf16x8, a); pf[2 + s] = __builtin_bit_cast(bf16x8, b); }
#pragma unroll
    for (int dt = 0; dt < 2; ++dt)
#pragma unroll
        for (int ks = 0; ks < 4; ++ks) { const bf16x8 a = at_frag(vl, 32 * dt, ks); O[dt] = __builtin_amdgcn_mfma_f32_32x32x16_bf16(a, pf[ks], O[dt], 0, 0, 0); }
}
__device__ __forceinline__ float max3f(float a, float b, float c) { float r; asm("v_max3_f32 %0, %1, %2, %3" : "=v"(r) : "v"(a), "v"(b), "v"(c)); return r; }
__device__ __forceinline__ float at_rowmax(const f32x16& S0, const f32x16& S1) {
    float a = max3f(S0[0], S0[1], S1[0]), b = max3f(S0[2], S0[3], S1[1]); a = max3f(a, S1[2], S1[3]);
#pragma unroll
    for (int r = 4; r < 16; r += 4) { a = max3f(a, S0[r], S0[r + 1]); b = max3f(b, S0[r + 2], S0[r + 3]); a = max3f(a, S1[r], S1[r + 1]); b = max3f(b, S1[r + 2], S1[r + 3]); }
    float m2; asm("v_max_f32_e32 %0, %1, %2" : "=v"(m2) : "v"(a), "v"(b)); return m2;
}
__device__ __forceinline__ void at_softmax(f32x16& S0, f32x16& S1, float& m, float& l, f32x16 (&O)[2]) {
    const float mx = xh_max(at_rowmax(S0, S1));
    const float mn = fmaxf(m, mx);
    if (__any(mn > m)) { const float al = __builtin_amdgcn_exp2f((m - mn) * L2E); l *= al;
#pragma unroll
        for (int r = 0; r < 16; ++r) { O[0][r] *= al; O[1][r] *= al; } }
    m = mn; const float mL = mn * L2E; float sm = 0.f;
#pragma unroll
    for (int r = 0; r < 16; ++r) { S0[r] = __builtin_amdgcn_exp2f(__builtin_fmaf(S0[r], L2E, -mL)); S1[r] = __builtin_amdgcn_exp2f(__builtin_fmaf(S1[r], L2E, -mL)); sm += S0[r] + S1[r]; }
    l += sm;
}

__device__ __forceinline__ void attn_unit(int b, int jq, const bf16_t* __restrict__ Q, const bf16_t* __restrict__ CK, const bf16_t* __restrict__ CVp, const bf16_t* __restrict__ KS, const bf16_t* __restrict__ VSp,
                                          const bf16_t* __restrict__ KW, const bf16_t* __restrict__ VWp, const float* __restrict__ GATES, const float* __restrict__ g_b, bf16_t* CAT,
                                          LAS unsigned char* lds, int tid, int lane, int wave) {
    asm volatile("" : "+v"(lane), "+v"(tid));
    const int g = wave >> 2, wq = wave & 3, bg = 2 * b + g, r32 = lane & 31, h = lane >> 5, qi = r32 >> 2, hd = r32 & 3, htid = tid & 255;
    const int t = 32 * jq + 8 * wq + qi, cur = jq >> 1; const size_t tok = (size_t)b * SEQ + t;
    LAS float* IMPALL = (LAS float*)(lds + AT_IMP); LAS float* IMP = IMPALL + (g * 32 + 8 * wq + qi) * 128;
    LAS unsigned* SELM = (LAS unsigned*)(lds + AT_SELM); LAS float* OBSQ = (LAS float*)(lds + AT_OBSQ);
    const int srow = htid >> 3, sch = htid & 7, soff = srow * AT_ROW + sch * 16;
    const int lpart = r32 * AT_ROW + h * 16;
    v4u sr[4]; int bi = 0;
#define AT_LOAD_K(ptr, stride) do { sr[0] = *(const v4u*)((ptr) + (size_t)srow * (stride) + 8 * sch); sr[1] = *(const v4u*)((ptr) + (size_t)(srow + 32) * (stride) + 8 * sch); } while (0)
#define AT_LOAD_V(ptr, stride) do { sr[2] = *(const v4u*)((ptr) + (size_t)srow * (stride) + 8 * sch); sr[3] = *(const v4u*)((ptr) + (size_t)(srow + 32) * (stride) + 8 * sch); } while (0)
#define AT_STORE_K(bufi) do { LAS unsigned char* d_ = lds + at_tile_off(bufi, g, 0) + soff; *(LAS v4u*)d_ = sr[0]; *(LAS v4u*)(d_ + 32 * AT_ROW) = sr[1]; } while (0)
#define AT_STORE_V(bufi) do { LAS unsigned char* d_ = lds + at_tile_off(bufi, g, 1) + soff; *(LAS v4u*)d_ = sr[2]; *(LAS v4u*)(d_ + 32 * AT_ROW) = sr[3]; } while (0)
    __syncthreads();
    bf16x8 qf[4];
#pragma unroll
    for (int s = 0; s < 4; ++s) qf[s] = *(const bf16x8*)(Q + tok * 512 + (4 * g + hd) * 64 + 16 * s + 8 * h);
    { LAS float* z = IMPALL + (g * 32 + 8 * wq) * 128;
#pragma unroll
      for (int i = 0; i < 16; ++i) z[lane + 64 * i] = 0.f; }
    if (tid < 256) SELM[tid] = 0u;
    f32x16 S0, S1, O[2], oacc[2];
    const float* gt = GATES + tok * 24 + (4 * g + hd) * 3; const float g0 = gt[0], g1 = gt[1], g2 = gt[2];

    const int nct = (2 * jq + 1 + 63) >> 6; const int cmax = (t >= 31) ? ((t - 31) >> 4) : -1;
    const bf16_t* Kc = CK + (size_t)bg * NCP * 64; const bf16_t* Vc = CVp + (size_t)bg * 64 * NCP;
    float m = MINIT, l = 0.f;
    AT_LOAD_K(Kc, 64); AT_STORE_K(bi); __syncthreads();
#pragma unroll 1
    for (int ct = 0; ct < nct; ++ct) {
        if (ct + 1 < nct) AT_LOAD_K(Kc + (size_t)(ct + 1) * 64 * 64, 64);
        at_qk(lds + at_tile_off(bi, g, 0) + lpart, qf, S0, S1);
#pragma unroll
        for (int r = 0; r < 16; ++r) { const int thr = cmax - 64 * ct - 4 * h; if (at_key(0, r, 0) > thr) S0[r] = MASKV; if (at_key(1, r, 0) > thr) S1[r] = MASKV; }
        const float mx = xh_max(at_rowmax(S0, S1));
        const float mn = fmaxf(m, mx); l *= __builtin_amdgcn_exp2f((m - mn) * L2E); m = mn; const float mL0 = mn * L2E; float sm = 0.f;
#pragma unroll
        for (int r = 0; r < 16; ++r) sm += __builtin_amdgcn_exp2f(__builtin_fmaf(S0[r], L2E, -mL0)) + __builtin_amdgcn_exp2f(__builtin_fmaf(S1[r], L2E, -mL0));
        l += sm;
        if (ct + 1 < nct) AT_STORE_K(bi ^ 1);
        __syncthreads(); bi ^= 1;
    }
    l = xh_sum(l);
    const float inv_l = 1.0f / fmaxf(l, 1e-30f), mLc = m * L2E;
#pragma unroll
    for (int r = 0; r < 16; ++r) { O[0][r] = 0.f; O[1][r] = 0.f; }
    AT_LOAD_K(Kc, 64); AT_LOAD_V(Vc, NCP); AT_STORE_K(bi); AT_STORE_V(bi); __syncthreads();
#pragma unroll 1
    for (int ct = 0; ct < nct; ++ct) {
        if (ct + 1 < nct) { AT_LOAD_K(Kc + (size_t)(ct + 1) * 64 * 64, 64); AT_LOAD_V(Vc + (size_t)(ct + 1) * 64, NCP); }
        at_qk(lds + at_tile_off(bi, g, 0) + lpart, qf, S0, S1);
#pragma unroll
        for (int r = 0; r < 16; ++r) {
            const int thr = cmax - 64 * ct - 4 * h;
            S0[r] = (at_key(0, r, 0) > thr) ? 0.f : __builtin_amdgcn_exp2f(__builtin_fmaf(S0[r], L2E, -mLc)) * inv_l;
            S1[r] = (at_key(1, r, 0) > thr) ? 0.f : __builtin_amdgcn_exp2f(__builtin_fmaf(S1[r], L2E, -mLc)) * inv_l; }
#pragma unroll
        for (int mt = 0; mt < 2; ++mt)
#pragma unroll
            for (int k = 0; k < 4; ++k) {
                const float p0 = mt ? S1[4 * k] : S0[4 * k], p1 = mt ? S1[4 * k + 1] : S0[4 * k + 1], p2 = mt ? S1[4 * k + 2] : S0[4 * k + 2], p3 = mt ? S1[4 * k + 3] : S0[4 * k + 3];
                float bs = (p0 + p1) + (p2 + p3), ts = p3;
                bs = quad_sum(bs); ts = quad_sum(ts);
                const int blk = 16 * ct + 8 * mt + 2 * k + h;
                if (hd == 0) { __hip_atomic_fetch_add(IMP + blk, bs, __ATOMIC_RELAXED, __HIP_MEMORY_SCOPE_WORKGROUP);
                               if (blk + 1 < 128) __hip_atomic_fetch_add(IMP + blk + 1, ts, __ATOMIC_RELAXED, __HIP_MEMORY_SCOPE_WORKGROUP); }
            }
        at_pv(lds + at_tile_off(bi, g, 1) + lpart, S0, S1, O);
        if (ct + 1 < nct) { AT_STORE_K(bi ^ 1); AT_STORE_V(bi ^ 1); }
        __syncthreads(); bi ^= 1;
    }
#pragma unroll
    for (int r = 0; r < 16; ++r) { oacc[0][r] = g0 * O[0][r]; oacc[1][r] = g0 * O[1][r]; }
    {
        const int nforced = cur >= 2 ? 3 : cur + 1, need = 16 - nforced, ncand = cur - 2;
#pragma unroll 1
        for (int i = 0; i < 8; ++i) {
            const int row = wave * 8 + i; LAS float* ir = IMPALL + row * 128;
            const int s0 = lane, s1 = lane + 64;
            const bool c0 = (s0 >= 1 && s0 <= cur - 2), c1 = (s1 <= cur - 2);
            const unsigned x0 = c0 ? __float_as_uint(ir[s0]) + 1u : 0u, x1 = c1 ? __float_as_uint(ir[s1]) + 1u : 0u;
            bool sel0 = c0, sel1 = c1;
            if (ncand > need) {
                unsigned lo = 1u, hi = 0x7f800002u; bool exact = false;
                while (hi - lo > 1u) { const unsigned mid = lo + ((hi - lo) >> 1);
                    const int c = __popcll(__ballot(x0 >= mid)) + __popcll(__ballot(x1 >= mid));
                    if (c == need) { lo = mid; exact = true; break; }
                    if (c > need) lo = mid; else hi = mid; }
                if (exact) { sel0 = x0 >= lo; sel1 = x1 >= lo; }
                else { const unsigned long long gt0 = __ballot(x0 > lo), gt1 = __ballot(x1 > lo), eq0 = __ballot(x0 == lo), eq1 = __ballot(x1 == lo);
                    const int need2 = need - (__popcll(gt0) + __popcll(gt1)); const unsigned long long lm = (1ull << lane) - 1ull;
                    sel0 = (x0 > lo) || (x0 == lo && __popcll(eq0 & lm) < need2);
                    sel1 = (x1 > lo) || (x1 == lo && __popcll(eq0) + __popcll(eq1 & lm) < need2); }
            }
            const bool f0 = (s0 == 0) || (s0 == cur) || (s0 == cur - 1), f1 = (s1 == cur) || (s1 == cur - 1);
            const unsigned long long b0 = __ballot(sel0 || f0), b1 = __ballot(sel1 || f1);
            if (lane == 0) { SELM[row * 4] = (unsigned)b0; SELM[row * 4 + 1] = (unsigned)(b0 >> 32); SELM[row * 4 + 2] = (unsigned)b1; SELM[row * 4 + 3] = (unsigned)(b1 >> 32); }
        }
    }
    __syncthreads();
#ifndef REP_SEL
#define REP_SEL 1
#endif
#ifndef REP_WIN
#define REP_WIN 1
#endif
#ifndef REP_CMP
#define REP_CMP 1
#endif
#pragma unroll 1
    for (int rp_ = 0; rp_ < REP_SEL; ++rp_) {
        const LAS unsigned* sw = SELM + (g * 32 + 8 * wq + qi) * 4; const unsigned sw0 = sw[0], sw1 = sw[1], sw2 = sw[2], sw3 = sw[3];
        const bf16_t* Ks = KS + (size_t)bg * SEQ * 64; const bf16_t* Vs = VSp + (size_t)bg * 64 * SEQ;
        m = MINIT; l = 0.f;
#pragma unroll
        for (int r = 0; r < 16; ++r) { O[0][r] = 0.f; O[1][r] = 0.f; }
        AT_LOAD_K(Ks, 64); AT_LOAD_V(Vs, SEQ); AT_STORE_K(bi); AT_STORE_V(bi); __syncthreads();
#pragma unroll 1
        for (int blk = 0; blk <= cur; ++blk) {
            if (blk < cur) { AT_LOAD_K(Ks + (size_t)(blk + 1) * 64 * 64, 64); AT_LOAD_V(Vs + (size_t)(blk + 1) * 64, SEQ); }
            const unsigned w = blk < 32 ? sw0 : blk < 64 ? sw1 : blk < 96 ? sw2 : sw3; const bool on = (w >> (blk & 31)) & 1u;
            if (__any(on)) {
                at_qk(lds + at_tile_off(bi, g, 0) + lpart, qf, S0, S1);
                if (blk == cur) {
#pragma unroll
                    for (int r = 0; r < 16; ++r) { const int thr = on ? t - 64 * blk - 4 * h : -1; if (at_key(0, r, 0) > thr) S0[r] = MASKV; if (at_key(1, r, 0) > thr) S1[r] = MASKV; }
                } else if (!__all(on)) {
#pragma unroll
                    for (int r = 0; r < 16; ++r) { if (!on) { S0[r] = MASKV; S1[r] = MASKV; } }
                }
                at_softmax(S0, S1, m, l, O);
                at_pv(lds + at_tile_off(bi, g, 1) + lpart, S0, S1, O);
            }
            if (blk < cur) { AT_STORE_K(bi ^ 1); AT_STORE_V(bi ^ 1); }
            __syncthreads(); bi ^= 1;
        }
        l = xh_sum(l); const float f = (rp_ == REP_SEL - 1) ? g1 / l : 0.f;
#pragma unroll
        for (int r = 0; r < 16; ++r) { oacc[0][r] += f * O[0][r]; oacc[1][r] += f * O[1][r]; }
    }
#pragma unroll 1
    for (int rp_ = 0; rp_ < REP_WIN; ++rp_) {
        const int wb0 = cur > 8 ? cur - 8 : 0;
        const bf16_t* Kw = KW + (size_t)bg * SEQ * 64; const bf16_t* Vw = VWp + (size_t)bg * 64 * SEQ;
        m = MINIT; l = 0.f;
#pragma unroll
        for (int r = 0; r < 16; ++r) { O[0][r] = 0.f; O[1][r] = 0.f; }
        AT_LOAD_K(Kw + (size_t)wb0 * 64 * 64, 64); AT_LOAD_V(Vw + (size_t)wb0 * 64, SEQ); AT_STORE_K(bi); AT_STORE_V(bi); __syncthreads();
#pragma unroll 1
        for (int blk = wb0; blk <= cur; ++blk) {
            if (blk < cur) { AT_LOAD_K(Kw + (size_t)(blk + 1) * 64 * 64, 64); AT_LOAD_V(Vw + (size_t)(blk + 1) * 64, SEQ); }
            at_qk(lds + at_tile_off(bi, g, 0) + lpart, qf, S0, S1);
            if (blk == cur || blk + 8 == cur) {
#pragma unroll
                for (int r = 0; r < 16; ++r) { const int hi_ = t - 64 * blk - 4 * h, lo_ = hi_ - WIN;
                    if (at_key(0, r, 0) > hi_ || at_key(0, r, 0) <= lo_) S0[r] = MASKV; if (at_key(1, r, 0) > hi_ || at_key(1, r, 0) <= lo_) S1[r] = MASKV; }
            }
            at_softmax(S0, S1, m, l, O);
            at_pv(lds + at_tile_off(bi, g, 1) + lpart, S0, S1, O);
            if (blk < cur) { AT_STORE_K(bi ^ 1); AT_STORE_V(bi ^ 1); }
            __syncthreads(); bi ^= 1;
        }
        l = xh_sum(l); const float f = (rp_ == REP_WIN - 1) ? g2 / l : 0.f;
#pragma unroll
        for (int r = 0; r < 16; ++r) { oacc[0][r] += f * O[0][r]; oacc[1][r] += f * O[1][r]; }
    }
    {
        float q = 0.f;
#pragma unroll
        for (int r = 0; r < 16; ++r) q += oacc[0][r] * oacc[0][r] + oacc[1][r] * oacc[1][r];
        q = xh_sum(q); q = quad_sum(q);
        if (hd == 0 && h == 0) OBSQ[g * 32 + 8 * wq + qi] = q;
        __syncthreads();
        const float rb = rsqrtf((OBSQ[8 * wq + qi] + OBSQ[32 + 8 * wq + qi]) * (1.f / 512.f) + EPS);
#pragma unroll
        for (int dt = 0; dt < 2; ++dt)
#pragma unroll
            for (int rg = 0; rg < 4; ++rg) { const int col = (4 * g + hd) * 64 + 32 * dt + 8 * rg + 4 * h; const f32x4 gb = *(const f32x4*)(g_b + col);
                v2u w; w.x = pk2(oacc[dt][4 * rg] * rb * gb.x, oacc[dt][4 * rg + 1] * rb * gb.y); w.y = pk2(oacc[dt][4 * rg + 2] * rb * gb.z, oacc[dt][4 * rg + 3] * rb * gb.w);
                *(v2u*)(CAT + tok * 1024 + 512 + col) = w; }
    }
#undef AT_LOAD_K
#undef AT_LOAD_V
#undef AT_STORE_K
#undef AT_STORE_V
}

struct Args { const float* in[26]; float* out; unsigned char* ws; int ph_lo, ph_hi, li, pad; };

__global__ void __launch_bounds__(NWAVES * 64, 2) mk_fwd(Args args) {
    extern __shared__ __attribute__((aligned(16))) unsigned char lds_raw[];
    LAS unsigned char* lds = (LAS unsigned char*)lds_raw;
    const int tid = threadIdx.x, lane = tid & 63, wave = __builtin_amdgcn_readfirstlane(tid >> 6);
    const int G = gridDim.x; const int bx = blockIdx.x; const int vcu = (G % 8 == 0) ? (bx % 8) * (G / 8) + bx / 8 : bx;
    unsigned char* ws = args.ws;
    unsigned* ctl = (unsigned*)(ws + WS_CTL);
    for (int u = tid; u < (LDS_BYTES - LDSCTL_OFF) / 4; u += NWAVES * 64) ((LAS unsigned*)(lds + LDSCTL_OFF))[u] = 0u;
    __syncthreads();
    XcdBarrier bar = xcd_barrier_post(ctl + CW_BAR + args.li * XCD_BAR_WORDS, (volatile LAS unsigned*)(lds + LDSCTL_OFF + 320 + 32));
    const int lo = args.ph_lo, hi = args.ph_hi;
#ifndef REP_PHASE
#define REP_PHASE -1
#endif
#define REPN(k) (((k) == REP_PHASE) ? 2 : 1)
#define IN(k) (lo <= (k) && (k) < hi)
#define BOTH(k) (IN(k) && IN((k) + 1))
    const int gw = vcu * NWAVES + wave, NGW = G * NWAVES;

    float* ropeC = (float*)(ws + WS_ROPEC); float* ropeS = (float*)(ws + WS_ROPES);
    bf16_t* WT_IN = (bf16_t*)(ws + WS_WT_IN); bf16_t* HN = (bf16_t*)(ws + WS_HN);
    bf16_t* WT_O = (bf16_t*)(ws + WS_WT_O); bf16_t* WT_PG = (bf16_t*)(ws + WS_WT_PG); bf16_t* WT_PE = (bf16_t*)(ws + WS_WT_PE);
    bf16_t* WT_GU = (bf16_t*)(ws + WS_WT_GU); bf16_t* WT_D = (bf16_t*)(ws + WS_WT_D);
    bf16_t* PBF = (bf16_t*)(ws + WS_PBF); bf16_t* PP = (bf16_t*)(ws + WS_PP); bf16_t* HID = (bf16_t*)(ws + WS_HID); bf16_t* YS = (bf16_t*)(ws + WS_YS);
    bf16_t* W1T = (bf16_t*)(ws + WS_W1T); bf16_t* W2T = (bf16_t*)(ws + WS_W2T); float* CBIAS = (float*)(ws + WS_CBIAS); bf16_t* WTRI = (bf16_t*)(ws + WS_WTRI);
    unsigned char* rt_ = ws + WS_ROUTE;
    int* r_hist = (int*)(rt_ + R_HIST); int* r_toke = (int*)(rt_ + R_TOKE); float* r_tokw = (float*)(rt_ + R_TOKW); int* r_tokslot = (int*)(rt_ + R_TOKSLOT);
    int* r_slot2tok = (int*)(rt_ + R_SLOT2TOK); int* r_tile2e = (int*)(rt_ + R_TILE2E); int* r_nrt = (int*)(rt_ + R_NRT);
    float* r_rstd = (float*)(rt_ + R_RSTD); float* r_slotrs = (float*)(rt_ + R_SLOTRS); float* RWT = (float*)(ws + WS_RWT); float* HSQ = (float*)(ws + WS_HSQ);
    float* out = args.out;

    if (IN(0)) for (int rep_ = 0; rep_ < REPN(0); ++rep_) {
        LAS float* scr = (LAS float*)(lds + wave * 16384);
        constexpr int I_IN = 16 * (N_IN_PAD / 32);
        constexpr int I_O = 16 * 32, I_PG = 16 * 32, I_PE = 4 * 32;
        constexpr int I_G = 16 * 16 * 16, I_U = I_G, I_D = 16 * 8 * 32;
        constexpr int NITEMS = I_IN + I_O + I_PG + I_PE + I_G + I_U + I_D;
        constexpr int NDEFER = 6144;
#define CONV_ITEM(it_) do { \
            int r = (it_); \
            if (r < I_IN) { const int kb = r / (N_IN_PAD / 32), nb = r % (N_IN_PAD / 32); \
                p0_transpose_item(args.in[3], D_IN, D_IN, WT_IN, 1024, [](int c) { return in_dest_row(c); }, scr, 64 * kb, 32 * nb, lane); break; } r -= I_IN; \
            if (r < I_O) { p0_transpose_item(args.in[15], 1024, 1024, WT_O, 1024, [](int c) { return nat_dest_row(c); }, scr, 64 * (r / 32), 32 * (r % 32), lane); break; } r -= I_O; \
            if (r < I_PG) { p0_transpose_item(args.in[24], 1024, 1024, WT_PG, 1024, [](int c) { return nat_dest_row(c); }, scr, 64 * (r / 32), 32 * (r % 32), lane); break; } r -= I_PG; \
            if (r < I_PE) { p0_transpose_item(args.in[23], 1024, 1024, WT_PE, 256, [](int c) { return nat_dest_row(c); }, scr, 64 * (r / 32), 32 * (r % 32), lane); break; } r -= I_PE; \
            if (r < I_G) { const int e = r >> 8, kb = (r >> 4) & 15, nb = r & 15; \
                p0_transpose_item(args.in[19] + (size_t)e * 1024 * 512, 512, 512, WT_GU + (size_t)e * 1024 * 1024, 1024, [](int c) { return gu_dest_row(c); }, scr, 64 * kb, 32 * nb, lane); break; } r -= I_G; \
            if (r < I_U) { const int e = r >> 8, kb = (r >> 4) & 15, nb = r & 15; \
                p0_transpose_item(args.in[20] + (size_t)e * 1024 * 512, 512, 512, WT_GU + (size_t)e * 1024 * 1024, 1024, [](int c) { return gu_dest_row(c) + 16; }, scr, 64 * kb, 32 * nb, lane); break; } r -= I_U; \
            { const int e = r >> 8, kb = (r >> 5) & 7, nb = r & 31; \
                p0_transpose_item(args.in[21] + (size_t)e * 512 * 1024, 1024, 1024, WT_D + (size_t)e * 1024 * 512, 512, [](int c) { return nat_dest_row(c); }, scr, 64 * kb, 32 * nb, lane); } \
 \
        } while (0)
        for (int it = gw; it < NITEMS - NDEFER; it += NGW) CONV_ITEM(it);
        for (int it = gw; it < 2 * 256 + 2 * 8 + 128; it += NGW) {
            int r = it;
            if (r < 512) { const int kv = r >> 8, kb = (r >> 3) & 31, nb = r & 7;
                p0_transpose_item(args.in[kv ? 11 : 8], 256, 256, W1T + (size_t)kv * 256 * 2048, 2048, [](int c) { return c; }, scr, 64 * kb, 32 * nb, lane); continue; } r -= 512;
            if (r < 16) { const int kv = r >> 3, kb = (r >> 1) & 3, nb = r & 1;
                p0_transpose_item(args.in[kv ? 12 : 9], 64, 64, W2T + (size_t)kv * 64 * 256, 256, [](int c) { return c; }, scr, 64 * kb, 32 * nb, lane); continue; } r -= 16;
            { const int kv = r >> 6, nq = r & 63; const float* pe = args.in[kv ? 10 : 7]; const float* w1 = args.in[kv ? 11 : 8];
              f32x4 a = (f32x4){0.f, 0.f, 0.f, 0.f};
              for (int k = lane; k < 2048; k += 64) { const float pv = pe[k]; const f32x4 w4 = *(const f32x4*)(w1 + (size_t)k * 256 + 4 * nq); a.x += pv * w4.x; a.y += pv * w4.y; a.z += pv * w4.z; a.w += pv * w4.w; }
              a.x = wave_sum(a.x); a.y = wave_sum(a.y); a.z = wave_sum(a.z); a.w = wave_sum(a.w);
              if (lane == 0) *(f32x4*)(CBIAS + kv * 256 + 4 * nq) = a; }
        }
        { const float* rg = args.in[17]; const float* re = args.in[18]; const float* gm = args.in[16];
          for (int i = vcu * NWAVES * 64 + tid; i < 20 * 1024; i += G * NWAVES * 64) { const int c = i >> 10, k = i & 1023; RWT[i] = gm[k] * (c < 4 ? rg[k * 4 + c] : re[k * 16 + (c - 4)]); } }
        { const float* wsrc = args.in[5];
          for (int i = vcu * NWAVES * 64 + tid; i < 8 * 128 * 128; i += G * NWAVES * 64) { const int t = (i >> 7) & 127, sidx = i & 127; WTRI[i] = f2bf(sidx <= t ? wsrc[i] : 0.f); } }
        for (int i = (vcu * NWAVES * 64 + tid); i < SEQ * 32; i += G * NWAVES * 64) { const int pos = i >> 5, f = i & 31;
            double rev = (double)pos * ROPE_REV[f]; rev -= floor(rev); const float rr = (float)rev;
            ropeC[i] = __builtin_amdgcn_cosf(rr); ropeS[i] = __builtin_amdgcn_sinf(rr); }
        for (int m = gw; m < NTOK; m += NGW) rms_row_to_bf16(args.in[0] + (size_t)m * 1024, args.in[2], HN + (size_t)m * 1024, lane);
        { const f32x4* ps = (const f32x4*)args.in[1]; v2u* pd = (v2u*)PBF;
          for (int i = vcu * NWAVES * 64 + tid; i < NTOK * 256 / 4; i += G * NWAVES * 64) { const f32x4 v = ps[i]; v2u o; o.x = pk2(v.x, v.y); o.y = pk2(v.z, v.w); pd[i] = o; } }
        if (BOTH(0)) xcd_barrier(bar);
    }
    if (IN(1)) for (int rep_ = 0; rep_ < REPN(1); ++rep_) {
        pg8::Gemm g{HN, WT_IN, NTOK, N_IN_PAD, 1024, 1024, 1024, nullptr}; pg8::StaticOrder S; S.init(NTOK, N_IN_PAD, G, bx);
        EpiIn E{(bf16_t*)(ws + WS_U), (bf16_t*)(ws + WS_V), (bf16_t*)(ws + WS_Q), (bf16_t*)(ws + WS_KV), (float*)(ws + WS_GATES), ropeC, ropeS, (float*)(ws + WS_VSQ)};
        pg8::gemm_phase<EpiIn, pg8::StaticOrder, true, true>(lds, g, S, E);
        if (2 * bx >= G) {
            LAS float* scr = (LAS float*)(lds + wave * 16384);
            constexpr int I_IN = 16 * (N_IN_PAD / 32), I_O = 16 * 32, I_PG = 16 * 32, I_PE = 4 * 32, I_G = 16 * 16 * 16, I_U = I_G, I_D = 16 * 8 * 32, NITEMS = I_IN + I_O + I_PG + I_PE + I_G + I_U + I_D, NDEFER = 6144;
            const int nw2 = (G - G / 2) * NWAVES, w2 = (bx - G / 2) * NWAVES + wave;
            for (int it = NITEMS - NDEFER + w2; it < NITEMS; it += nw2) CONV_ITEM(it);
        }
        __syncthreads();
    }
    if (IN(2)) for (int rep_ = 0; rep_ < REPN(2); ++rep_) {
        pg8::Gemm g{PBF, WT_PE, NTOK, 1024, 256, 256, 256, nullptr}; pg8::StaticOrder S; S.init(NTOK, 1024, G, bx);
        EpiBf16N E{PP, 1024, 3};
        pg8::gemm_phase<EpiBf16N, pg8::StaticOrder, false, true>(lds, g, S, E);
        if (BOTH(2)) xcd_barrier(bar);
    }
    if (IN(3)) for (int rep_ = 0; rep_ < REPN(3); ++rep_) {
        for (int u = bx; u < 256; u += G) {
            if (u < 128) gmlp_unit(u, (const bf16_t*)(ws + WS_U), (const bf16_t*)(ws + WS_V), (const float*)(ws + WS_VSQ), WTRI, args.in[4], args.in[6], args.in[13], (bf16_t*)(ws + WS_CAT), lds, tid, lane, wave);
            else compress_unit(u - 128, (const bf16_t*)(ws + WS_KV), W1T, W2T, CBIAS, (bf16_t*)(ws + WS_CK), (bf16_t*)(ws + WS_CV), lds, lane, wave);
        }
        if (BOTH(3)) xcd_barrier(bar);
    }
    if (IN(4)) for (int rep_ = 0; rep_ < REPN(4); ++rep_) {
        for (int it = bx; it < 256; it += G) { const int b = it & 1, jp = it >> 1;
#pragma unroll 1
            for (int u2 = 0; u2 < 2; ++u2)
                attn_unit(b, u2 ? jp : 255 - jp, (const bf16_t*)(ws + WS_Q), (const bf16_t*)(ws + WS_CK), (const bf16_t*)(ws + WS_CV), (const bf16_t*)(ws + WS_KV + 2 * KV_STRIDE), (const bf16_t*)(ws + WS_KV + 3 * KV_STRIDE),
                          (const bf16_t*)(ws + WS_KV + 4 * KV_STRIDE), (const bf16_t*)(ws + WS_KV + 5 * KV_STRIDE), (const float*)(ws + WS_GATES), args.in[14], (bf16_t*)(ws + WS_CAT), lds, tid, lane, wave); }
        if (BOTH(4)) xcd_barrier(bar);
    }
    if (IN(5)) for (int rep_ = 0; rep_ < REPN(5); ++rep_) {
        pg8::Gemm g{(const bf16_t*)(ws + WS_CAT), WT_O, NTOK, 1024, 1024, 1024, 1024, nullptr}; pg8::StaticOrder S; S.init(NTOK, 1024, G, bx);
        EpiWo E{args.in[0], out, HN, args.in[16], HSQ};
        pg8::gemm_phase<EpiWo, pg8::StaticOrder, false, true>(lds, g, S, E);
        if (BOTH(5)) xcd_barrier(bar);
    }
    if (IN(6)) for (int rep_ = 0; rep_ < REPN(6); ++rep_) {
        LAS float* RW = (LAS float*)lds;
        LAS float* PART = (LAS float*)(lds + 82240);
        LAS float* LOG = (LAS float*)(lds + 82240 + 8192);
        LAS float* RS = (LAS float*)(lds + 82240 + 8192 + 5120);
        LAS int* lh = (LAS int*)(lds + 82240 + 8192 + 5120 + 256);
        { const f32x4* src = (const f32x4*)RWT; for (int i = tid; i < 20 * 256; i += NWAVES * 64) *(LAS f32x4*)(RW + (i >> 8) * 1028 + 4 * (i & 255)) = src[i]; }
        for (int ch = bx; ch < NTOK / 64; ch += G) {
        __syncthreads();
        if (tid < 16) lh[tid] = 0;
        if (tid < 64) { const f32x4* q4 = (const f32x4*)(HSQ + (size_t)(ch * 64 + tid) * 16); const f32x4 a = q4[0], b = q4[1], c = q4[2], d = q4[3];
            const float sm = ((a.x + a.y) + (a.z + a.w)) + ((b.x + b.y) + (b.z + b.w)) + ((c.x + c.y) + (c.z + c.w)) + ((d.x + d.y) + (d.z + d.w));
            const float rs = rsqrtf(sm * (1.f / 1024.f) + EPS); RS[tid] = rs; r_rstd[ch * 64 + tid] = rs; }
        const int tile = wave & 3, kh = wave >> 2, q = lane >> 4, cl = lane & 15;
        const float* xa = out + (size_t)(ch * 64 + 16 * tile + cl) * 1024 + 512 * kh + 4 * q;
        const LAS float* b0p = RW + cl * 1028 + 512 * kh + 4 * q; const LAS float* b1p = RW + (cl < 4 ? 16 + cl : 19) * 1028 + 512 * kh + 4 * q;
        pg8::f32x4 acc0 = {0.f, 0.f, 0.f, 0.f}, acc1 = {0.f, 0.f, 0.f, 0.f};
#pragma unroll 4
        for (int i = 0; i < 32; ++i) { const f32x4 a4 = *(const f32x4*)(xa + 16 * i); const f32x4 b40 = *(const LAS f32x4*)(b0p + 16 * i), b41 = *(const LAS f32x4*)(b1p + 16 * i);
            acc0 = __builtin_amdgcn_mfma_f32_16x16x4f32(a4.x, b40.x, acc0, 0, 0, 0); acc1 = __builtin_amdgcn_mfma_f32_16x16x4f32(a4.x, b41.x, acc1, 0, 0, 0);
            acc0 = __builtin_amdgcn_mfma_f32_16x16x4f32(a4.y, b40.y, acc0, 0, 0, 0); acc1 = __builtin_amdgcn_mfma_f32_16x16x4f32(a4.y, b41.y, acc1, 0, 0, 0);
            acc0 = __builtin_amdgcn_mfma_f32_16x16x4f32(a4.z, b40.z, acc0, 0, 0, 0); acc1 = __builtin_amdgcn_mfma_f32_16x16x4f32(a4.z, b41.z, acc1, 0, 0, 0);
            acc0 = __builtin_amdgcn_mfma_f32_16x16x4f32(a4.w, b40.w, acc0, 0, 0, 0); acc1 = __builtin_amdgcn_mfma_f32_16x16x4f32(a4.w, b41.w, acc1, 0, 0, 0); }
        if (kh == 1) {
#pragma unroll
            for (int rg2 = 0; rg2 < 4; ++rg2) { PART[(tile * 16 + 4 * q + rg2) * 32 + cl] = acc0[rg2]; PART[(tile * 16 + 4 * q + rg2) * 32 + 16 + cl] = acc1[rg2]; } }
        __syncthreads();
        if (kh == 0) {
#pragma unroll
            for (int rg2 = 0; rg2 < 4; ++rg2) { const int tl = tile * 16 + 4 * q + rg2; const float rs = RS[tl];
                LOG[tl * 20 + cl] = (acc0[rg2] + PART[tl * 32 + cl]) * rs; if (cl < 4) LOG[tl * 20 + 16 + cl] = (acc1[rg2] + PART[tl * 32 + 16 + cl]) * rs; } }
        __syncthreads();
        if (tid < 64) {
            const int tok = ch * 64 + tid; float lg[20];
#pragma unroll
            for (int j = 0; j < 20; ++j) lg[j] = LOG[tid * 20 + j];
            int gs = 0; float gm = lg[0];
#pragma unroll
            for (int j = 1; j < 4; ++j) if (lg[j] > gm) { gm = lg[j]; gs = j; }
            float den = 0.f;
#pragma unroll
            for (int j = 0; j < 4; ++j) den += __expf(lg[j] - gm);
            const float pg = 1.0f / den;
            float le[4];
#pragma unroll
            for (int j = 0; j < 4; ++j) le[j] = gs == 0 ? lg[4 + j] : gs == 1 ? lg[8 + j] : gs == 2 ? lg[12 + j] : lg[16 + j];
            float b0 = le[0]; int e0 = 0;
#pragma unroll
            for (int j = 1; j < 4; ++j) if (le[j] > b0) { b0 = le[j]; e0 = j; }
            float b1 = -3.0e38f; int e1 = -1;
#pragma unroll
            for (int j = 0; j < 4; ++j) if (j != e0 && (e1 < 0 || le[j] > b1)) { b1 = le[j]; e1 = j; }
            const float p1 = __expf(b1 - b0);
            const int E0 = gs * 4 + e0, E1 = gs * 4 + e1;
            r_toke[tok * 2] = E0; r_toke[tok * 2 + 1] = E1; r_tokw[tok * 2] = pg / (1.0f + p1); r_tokw[tok * 2 + 1] = pg * p1 / (1.0f + p1);
            atomicAdd((int*)(lh + E0), 1); atomicAdd((int*)(lh + E1), 1);
        }
        __syncthreads();
        if (tid < 16) r_hist[ch * 16 + tid] = lh[tid];
        }
        if (BOTH(6)) xcd_barrier(bar);
    }
    if (IN(7)) for (int rep_ = 0; rep_ < REPN(7); ++rep_) {
        LAS int* l_cnt = (LAS int*)lds; LAS int* l_pre = l_cnt + 16; LAS int* l_base = l_cnt + 32; LAS int* l_e = l_cnt + 64; LAS int* l_hist = l_cnt + 256;
        for (int ch = bx; ch < NTOK / 64; ch += G) {
        __syncthreads();
        { const v4u* hsrc = (const v4u*)r_hist; for (int i = tid; i < (NTOK / 64) * 4; i += NWAVES * 64) *(LAS v4u*)(l_hist + 4 * i) = hsrc[i]; }
        if (tid < 128) l_e[tid] = r_toke[ch * 128 + tid];
        __syncthreads();
        if (tid < 16) { int c = 0, pre = 0; for (int q = 0; q < NTOK / 64; ++q) { const int hv = l_hist[q * 16 + tid]; c += hv; if (q < ch) pre += hv; } l_cnt[tid] = c; l_pre[tid] = pre; }
        __syncthreads();
        if (tid == 0) { int a = 0; for (int e = 0; e < 16; ++e) { l_base[e] = a; a += (l_cnt[e] + 255) & ~255; }
            if (ch == 0) { int rt = 0; for (int e = 0; e < 16; ++e) { const int nt = (l_cnt[e] + 255) >> 8; for (int j = 0; j < nt; ++j) r_tile2e[rt++] = e; } *r_nrt = rt; } }
        __syncthreads();
        if (tid < 128) { const int e = l_e[tid]; int pos = 0; for (int j = 0; j < tid; ++j) pos += (l_e[j] == e) ? 1 : 0;
            const int slot = l_base[e] + l_pre[e] + pos; r_tokslot[ch * 128 + tid] = slot; r_slot2tok[slot] = ch * 64 + (tid >> 1); r_slotrs[slot] = r_rstd[ch * 64 + (tid >> 1)]; }
        if (ch < 16) { const int e = ch, c = l_cnt[e], cp = (c + 255) & ~255; for (int s2 = c + tid; s2 < cp; s2 += NWAVES * 64) { r_slot2tok[l_base[e] + s2] = 0; r_slotrs[l_base[e] + s2] = 0.f; } }
        }
        if (BOTH(7)) xcd_barrier(bar);
    }
    if (IN(8)) for (int rep_ = 0; rep_ < REPN(8); ++rep_) {
        pg8::Gemm g{HN, WT_GU, MAXSLOT, 16 * 1024, 1024, 1024, 1024, r_slot2tok}; MoeOrder S{*r_nrt * 4, G, bx, r_tile2e};
        EpiGU E{HID, r_slotrs};
        pg8::gemm_phase<EpiGU, MoeOrder, true, true, true>(lds, g, S, E);
        if (BOTH(8)) xcd_barrier(bar);
    }
    if (IN(9)) for (int rep_ = 0; rep_ < REPN(9); ++rep_) {
        pg8::Gemm g{HID, WT_D, MAXSLOT, 16 * 1024, 512, 512, 512, nullptr}; MoeOrder S{*r_nrt * 4, G, bx, r_tile2e};
        EpiBf16N E{YS, 1024, 3};
        pg8::gemm_phase<EpiBf16N, MoeOrder, true, true>(lds, g, S, E);
        if (BOTH(9)) xcd_barrier(bar);
    }
    if (IN(10)) for (int rep_ = 0; rep_ < REPN(10); ++rep_) {
        const float* gple = args.in[22];
        for (int tok = gw; tok < NTOK; tok += NGW) {
            const int s0 = r_tokslot[tok * 2], s1 = r_tokslot[tok * 2 + 1]; const float w0 = r_tokw[tok * 2], w1 = r_tokw[tok * 2 + 1];
            f32x4* xr = (f32x4*)(out + (size_t)tok * 1024) + lane; const v2u* y0 = (const v2u*)(YS + (size_t)s0 * 1024) + lane; const v2u* y1 = (const v2u*)(YS + (size_t)s1 * 1024) + lane;
            const f32x4* gr = (const f32x4*)gple + lane;
            f32x4 v[4]; float s = 0.f;
#pragma unroll
            for (int j = 0; j < 4; ++j) { v[j] = xr[64 * j]; const v2u a = y0[64 * j], b = y1[64 * j];
                v[j].x += w0 * __uint_as_float(a.x << 16) + w1 * __uint_as_float(b.x << 16); v[j].y += w0 * __uint_as_float(a.x & 0xffff0000u) + w1 * __uint_as_float(b.x & 0xffff0000u);
                v[j].z += w0 * __uint_as_float(a.y << 16) + w1 * __uint_as_float(b.y << 16); v[j].w += w0 * __uint_as_float(a.y & 0xffff0000u) + w1 * __uint_as_float(b.y & 0xffff0000u);
                xr[64 * j] = v[j]; s += (v[j].x * v[j].x + v[j].y * v[j].y) + (v[j].z * v[j].z + v[j].w * v[j].w); }
            const float r = rsqrtf(wave_sum(s) * (1.f / 1024.f) + EPS);
            v2u* o8 = (v2u*)(HN + (size_t)tok * 1024) + lane;
#pragma unroll
            for (int j = 0; j < 4; ++j) { const f32x4 g4 = gr[64 * j]; v2u o; o.x = pk2(v[j].x * r * g4.x, v[j].y * r * g4.y); o.y = pk2(v[j].z * r * g4.z, v[j].w * r * g4.w); o8[64 * j] = o; }
        }
        if (BOTH(10)) xcd_barrier(bar);
    }
    if (IN(11)) for (int rep_ = 0; rep_ < REPN(11); ++rep_) {
        pg8::Gemm g{HN, WT_PG, NTOK, 1024, 1024, 1024, 1024, nullptr}; pg8::StaticOrder S; S.init(NTOK, 1024, G, bx);
        EpiPle E{PP, out};
        pg8::gemm_phase<EpiPle, pg8::StaticOrder, false, true>(lds, g, S, E);
        if (BOTH(11)) xcd_barrier(bar);
    }
    if (IN(12)) for (int rep_ = 0; rep_ < REPN(12); ++rep_) {
        const float* gf = args.in[25];
        for (int tok = gw; tok < NTOK; tok += NGW) {
            f32x4* xr = (f32x4*)(out + (size_t)tok * 1024) + lane; const f32x4* gr = (const f32x4*)gf + lane;
            f32x4 v[4]; float s = 0.f;
#pragma unroll
            for (int j = 0; j < 4; ++j) { v[j] = xr[64 * j]; s += (v[j].x * v[j].x + v[j].y * v[j].y) + (v[j].z * v[j].z + v[j].w * v[j].w); }
            const float r = rsqrtf(wave_sum(s) * (1.f / 1024.f) + EPS);
#pragma unroll
            for (int j = 0; j < 4; ++j) { const f32x4 g4 = gr[64 * j]; xr[64 * j] = (f32x4){v[j].x * r * g4.x, v[j].y * r * g4.y, v[j].z * r * g4.z, v[j].w * r * g4.w}; }
        }
    }
#undef IN
#undef BOTH
}


extern "C" void kernel_launch(void* const* d_in, const int* in_sizes, int n_in, void* d_out, int out_size, void* d_ws, size_t ws_size, hipStream_t stream) {
    static int grid = 0;
    if (grid == 0) {
        int dev = 0, cus = 0, per_cu = 0;
        if (hipGetDevice(&dev) != hipSuccess || hipDeviceGetAttribute(&cus, hipDeviceAttributeMultiprocessorCount, dev) != hipSuccess) { fprintf(stderr, "kernel_launch: device query failed\n"); grid = -1; return; }
        if (hipFuncSetAttribute((const void*)mk_fwd, hipFuncAttributeMaxDynamicSharedMemorySize, LDS_BYTES) != hipSuccess) { fprintf(stderr, "kernel_launch: hipFuncSetAttribute failed\n"); grid = -1; return; }
        if (hipOccupancyMaxActiveBlocksPerMultiprocessor(&per_cu, (const void*)mk_fwd, NWAVES * 64, LDS_BYTES) != hipSuccess || per_cu < 1) { fprintf(stderr, "kernel_launch: occupancy query says %d blocks per CU\n", per_cu); (void)hipGetLastError(); grid = -1; return; }
        grid = cus;
    }
    if (grid < 0) return;
    const float* x = (const float*)d_in[0]; const float* p = (const float*)d_in[1];
    const float* g_v = (const float*)d_in[4]; const float* w_s = (const float*)d_in[5]; const float* b_s = (const float*)d_in[6];
    const float* pe_k = (const float*)d_in[7]; const float* w1_k = (const float*)d_in[8]; const float* w2_k = (const float*)d_in[9];
    const float* pe_v = (const float*)d_in[10]; const float* w1_v = (const float*)d_in[11]; const float* w2_v = (const float*)d_in[12];
    const float* g_a = (const float*)d_in[13]; const float* g_b = (const float*)d_in[14]; const float* w_o = (const float*)d_in[15];
    const float* norm_moe = (const float*)d_in[16]; const float* r_g = (const float*)d_in[17]; const float* r_e = (const float*)d_in[18];
    const float* wg = (const float*)d_in[19]; const float* wu = (const float*)d_in[20]; const float* wd = (const float*)d_in[21];
    const float* norm_ple = (const float*)d_in[22]; const float* w_pe = (const float*)d_in[23]; const float* w_pg = (const float*)d_in[24]; const float* norm_final = (const float*)d_in[25];
    float* out = (float*)d_out;
    WS w = make_ws(d_ws);
    (void)hipMemsetAsync((char*)d_ws + WS_CTL, 0, CTL_ZERO_BYTES, stream);
    Args a{};
    for (int i = 0; i < 26; ++i) a.in[i] = (const float*)d_in[i];
    a.out = out; a.ws = (unsigned char*)d_ws;
    a.ph_lo = 0; a.ph_hi = 13; a.li = 0;
    hipLaunchKernelGGL(mk_fwd, dim3(grid), dim3(NWAVES * 64), LDS_BYTES, stream, a);
}
```
